# Optimizing an MI355X kernel written in HIP

```python
import math
import jax, jax.numpy as jnp
from jax import lax
import numpy as np

D_MODEL = 2048
BATCH = 4
SEQ = 2048
DEPTH = 2

N_META = 16
BLK = 128
ROPE_THETA = 10000.0
NORM_EPS = 1e-5
NEG = -1e30
SWA_HEADS = 12
SWA_KV_HEADS = 4
SWA_HEAD_DIM = 64
SWA_WINDOW = 128
SWA_WIDTH = SWA_HEADS * SWA_HEAD_DIM
SWA_KV_WIDTH = SWA_KV_HEADS * SWA_HEAD_DIM
SSM_WIDTH = 768
SSM_GROUP = 16
SSM_GROUPS = SSM_WIDTH // SSM_GROUP
SSM_STATE = 64
DT_MIN = 1e-3
DT_MAX = 1e-1
DIFF_HEADS = 4
DIFF_QK_DIM = 64
DIFF_V_DIM = 128
DIFF_WIDTH = DIFF_HEADS * DIFF_V_DIM
DIFF_QK_WIDTH = DIFF_HEADS * 2 * DIFF_QK_DIM
MIX_WIDTH = SWA_WIDTH + SSM_WIDTH + DIFF_WIDTH
IN_SPLITS = (SWA_WIDTH, SWA_KV_WIDTH, SWA_KV_WIDTH, SSM_WIDTH, DIFF_QK_WIDTH, DIFF_QK_WIDTH, DIFF_WIDTH)
IN_WIDTH = sum(IN_SPLITS)
N_EXPERT_GROUPS = 4
EXPERTS_PER_GROUP = 8
N_EXPERTS = N_EXPERT_GROUPS * EXPERTS_PER_GROUP
TOP_K = 2
D_EXPERT = 512

kernel_name = "hymba_style_swa_s5_diffattn_hiermoe"


def _split_points(sizes):
    pts, acc = [], 0
    for s in sizes[:-1]:
        acc += s
        pts.append(acc)
    return pts


def rms_norm(x, g):
    xf = x.astype(jnp.float32)
    y = xf * lax.rsqrt(jnp.mean(xf * xf, axis=-1, keepdims=True) + NORM_EPS)
    return (y * g.astype(jnp.float32)).astype(x.dtype)


def rope(x, pos):
    half = x.shape[-1] // 2
    inv = ROPE_THETA ** (-jnp.arange(half, dtype=jnp.float32) / half)
    ang = pos.astype(jnp.float32)[:, None] * inv[None, :]
    cos = jnp.cos(ang)[None, :, None, :]
    sin = jnp.sin(ang)[None, :, None, :]
    xf = x.astype(jnp.float32)
    x1, x2 = xf[..., :half], xf[..., half:]
    return jnp.concatenate([x1 * cos - x2 * sin, x2 * cos + x1 * sin], axis=-1).astype(x.dtype)


def pad_front(t, pad):
    return jnp.pad(t, ((0, 0), (pad, 0)) + ((0, 0),) * (t.ndim - 2))


def sliding_window_attention(q, k, v, sinks, pad):
    b, lp, hq, d = q.shape
    hkv = k.shape[2]
    grp = hq // hkv
    nb = lp // BLK
    qb = q.reshape(b, nb, BLK, hkv, grp, d)

    def with_prev(t):
        t = t.reshape(b, nb, BLK, hkv, d)
        prev = jnp.concatenate([jnp.zeros_like(t[:, :1]), t[:, :-1]], axis=1)
        return jnp.concatenate([prev, t], axis=2)

    kw, vw = with_prev(k), with_prev(v)
    s = jnp.einsum('bnqhgd,bnkhd->bhgnqk', qb, kw, preferred_element_type=jnp.float32) * (d ** -0.5)
    qi = jnp.arange(nb)[:, None] * BLK + jnp.arange(BLK)[None, :]
    kj = (jnp.arange(nb)[:, None] - 1) * BLK + jnp.arange(2 * BLK)[None, :]
    delta = qi[:, :, None] - kj[:, None, :]
    ok = (delta >= 0) & (delta < SWA_WINDOW) & (kj[:, None, :] >= pad)
    s = jnp.where(ok, s, NEG)
    sink = jnp.broadcast_to(sinks.astype(jnp.float32).reshape(hkv, grp)[None, :, :, None, None, None],
                            s.shape[:-1] + (1,))
    p = jax.nn.softmax(jnp.concatenate([s, sink], axis=-1), axis=-1)[..., :-1]
    o = jnp.einsum('bhgnqk,bnkhd->bnqhgd', p.astype(v.dtype), vw)
    return o.reshape(b, lp, hq * d)


def s5_ssm(u, lam_re, lam_im, b_re, b_im, c_re, c_im, d_skip, log_dt, w_glu):
    bsz, L, _ = u.shape
    G, P, H = SSM_GROUPS, SSM_STATE, SSM_GROUP
    f32 = jnp.float32
    uf = u.astype(f32).reshape(bsz, L, G, H)
    dt = jnp.exp(log_dt.astype(f32))[:, None]
    lr, li = lam_re.astype(f32), lam_im.astype(f32)
    mag = jnp.exp(lr * dt)
    abar_re, abar_im = mag * jnp.cos(li * dt), mag * jnp.sin(li * dt)
    den = lr * lr + li * li
    nr = abar_re - 1.0
    f_re = (nr * lr + abar_im * li) / den
    f_im = (abar_im * lr - nr * li) / den
    br, bi = b_re.astype(f32), b_im.astype(f32)
    bbar_re = f_re[..., None] * br - f_im[..., None] * bi
    bbar_im = f_re[..., None] * bi + f_im[..., None] * br
    bu_re = jnp.einsum('gph,blgh->lbgp', bbar_re, uf)
    bu_im = jnp.einsum('gph,blgh->lbgp', bbar_im, uf)
    a_re = jnp.broadcast_to(abar_re[None, None], (L, 1, G, P))
    a_im = jnp.broadcast_to(abar_im[None, None], (L, 1, G, P))

    def combine(e1, e2):
        a1r, a1i, b1r, b1i = e1
        a2r, a2i, b2r, b2i = e2
        return (a2r * a1r - a2i * a1i,
                a2r * a1i + a2i * a1r,
                a2r * b1r - a2i * b1i + b2r,
                a2r * b1i + a2i * b1r + b2i)

    _, _, xr, xi = lax.associative_scan(combine, (a_re, a_im, bu_re, bu_im), axis=0)
    y = (jnp.einsum('ghp,lbgp->blgh', c_re.astype(f32), xr)
         - jnp.einsum('ghp,lbgp->blgh', c_im.astype(f32), xi))
    y = y + d_skip.astype(f32).reshape(G, H) * uf
    y = jax.nn.gelu(y).reshape(bsz, L, SSM_WIDTH)
    y = y * jax.nn.sigmoid(y @ w_glu.astype(f32))
    return y.astype(u.dtype)


def differential_attention(q, k, v, lam, lam_init, subln_g, pad):
    b, lp = q.shape[:2]
    nb = lp // BLK
    scale = q.shape[-1] ** -0.5
    outs = []
    for n in range(nb):
        ke = (n + 1) * BLK
        s = jnp.einsum('bqhsd,bkhsd->bhsqk', q[:, n * BLK:ke], k[:, :ke],
                       preferred_element_type=jnp.float32) * scale
        qi = n * BLK + jnp.arange(BLK)
        kj = jnp.arange(ke)
        ok = (kj[None, :] <= qi[:, None]) & (kj[None, :] >= pad)
        p = jax.nn.softmax(jnp.where(ok, s, NEG), axis=-1)
        a = p[:, :, 0] - lam * p[:, :, 1]
        outs.append(jnp.einsum('bhqk,bkhd->bqhd', a.astype(v.dtype), v[:, :ke]))
    o = jnp.concatenate(outs, axis=1)
    o = rms_norm(o, subln_g) * (1.0 - lam_init)
    return o.reshape(b, lp, -1)


def hybrid_mixer(xn, pos, layer, w_in, swa_sinks, lam_re, lam_im, b_re, b_im, c_re, c_im, d_skip, log_dt,
                 w_glu, lq1, lk1, lq2, lk2, subln_g, w_out):
    b, L, _ = xn.shape
    pad = BLK - N_META
    proj = xn @ w_in
    qa, ka, va, us, qd, kd, vd = jnp.split(proj, _split_points(IN_SPLITS), axis=-1)
    qa = rope(qa.reshape(b, L, SWA_HEADS, SWA_HEAD_DIM), pos)
    ka = rope(ka.reshape(b, L, SWA_KV_HEADS, SWA_HEAD_DIM), pos)
    va = va.reshape(b, L, SWA_KV_HEADS, SWA_HEAD_DIM)
    o_a = sliding_window_attention(pad_front(qa, pad), pad_front(ka, pad), pad_front(va, pad),
                                   swa_sinks, pad)[:, pad:]
    o_b = s5_ssm(us, lam_re, lam_im, b_re, b_im, c_re, c_im, d_skip, log_dt, w_glu)
    qd = rope(qd.reshape(b, L, 2 * DIFF_HEADS, DIFF_QK_DIM), pos).reshape(b, L, DIFF_HEADS, 2, DIFF_QK_DIM)
    kd = rope(kd.reshape(b, L, 2 * DIFF_HEADS, DIFF_QK_DIM), pos).reshape(b, L, DIFF_HEADS, 2, DIFF_QK_DIM)
    vd = vd.reshape(b, L, DIFF_HEADS, DIFF_V_DIM)
    lam_init = 0.8 - 0.6 * math.exp(-0.3 * layer)
    f32 = jnp.float32
    lam = (jnp.exp(jnp.sum(lq1.astype(f32) * lk1.astype(f32)))
           - jnp.exp(jnp.sum(lq2.astype(f32) * lk2.astype(f32))) + lam_init)
    o_c = differential_attention(pad_front(qd, pad), pad_front(kd, pad), pad_front(vd, pad),
                                 lam, lam_init, subln_g, pad)[:, pad:]
    return jnp.concatenate([o_a, o_b, o_c], axis=-1) @ w_out


def hierarchical_moe(h, rg_w, rg_b, re_w, re_b, w_gate, w_up, w_down):
    n_tok, d = h.shape
    f32 = jnp.float32
    g_logits = (h @ rg_w + rg_b).astype(f32)
    g_prob = jax.nn.softmax(g_logits, axis=-1)
    g_sel = jnp.argmax(g_logits, axis=-1)
    p_g = jnp.take_along_axis(g_prob, g_sel[:, None], axis=1)
    e_logits = (h @ re_w + re_b).astype(f32).reshape(n_tok, N_EXPERT_GROUPS, EXPERTS_PER_GROUP)
    e_logits = jnp.take_along_axis(e_logits, g_sel[:, None, None], axis=1)[:, 0]
    top_w, top_i = lax.top_k(jax.nn.softmax(e_logits, axis=-1), TOP_K)
    top_w = top_w / jnp.sum(top_w, axis=-1, keepdims=True) * p_g
    expert = g_sel[:, None] * EXPERTS_PER_GROUP + top_i

    n_asg = n_tok * TOP_K
    e_flat = expert.reshape(n_asg)
    w_flat = top_w.reshape(n_asg)
    t_flat = jnp.arange(n_asg) // TOP_K
    order = jnp.argsort(e_flat)
    e_s, t_s, w_s = e_flat[order], t_flat[order], w_flat[order]
    counts = jnp.bincount(e_flat, length=N_EXPERTS)
    start = jnp.cumsum(counts) - counts
    padded = (counts + BLK - 1) // BLK * BLK
    pend = jnp.cumsum(padded)
    pstart = pend - padded
    dest = pstart[e_s] + (jnp.arange(n_asg) - start[e_s])
    n_blk = -(-n_asg // BLK) + N_EXPERTS
    rows = n_blk * BLK
    xbuf = jnp.zeros((rows, d), h.dtype).at[dest].set(h[t_s])
    blk_expert = jnp.clip(jnp.searchsorted(pend, jnp.arange(n_blk) * BLK, side='right'), 0, N_EXPERTS - 1)

    def expert_block(args):
        xb, e = args
        return (jax.nn.silu(xb @ w_gate[e]) * (xb @ w_up[e])) @ w_down[e]

    ybuf = lax.map(expert_block, (xbuf.reshape(n_blk, BLK, d), blk_expert)).reshape(rows, d)
    contrib = ybuf[dest] * w_s[:, None].astype(h.dtype)
    return jnp.zeros((n_tok, d), h.dtype).at[t_s].add(contrib)


def setup_inputs(seed: int = 0) -> dict:
    key = jax.random.key(seed)
    ks = jax.random.split(key, 29)
    f32 = jnp.float32

    def nrm(k, shape, scale):
        return jax.random.normal(k, shape, f32) * scale

    G, P, H = SSM_GROUPS, SSM_STATE, SSM_GROUP
    n_idx = jnp.arange(P, dtype=f32)
    return {
        "x": nrm(ks[0], (BATCH, SEQ, D_MODEL), 1.0),
        "meta_tokens": nrm(ks[1], (N_META, D_MODEL), 1.0),
        "attn_norm_g": 1.0 + nrm(ks[2], (DEPTH, D_MODEL), 0.02),
        "ffn_norm_g": 1.0 + nrm(ks[3], (DEPTH, D_MODEL), 0.02),
        "w_in": nrm(ks[4], (DEPTH, D_MODEL, IN_WIDTH), D_MODEL ** -0.5),
        "swa_sinks": nrm(ks[5], (DEPTH, SWA_HEADS), 0.5),
        "ssm_lambda_re": -0.5 + nrm(ks[6], (DEPTH, G, P), 0.01),
        "ssm_lambda_im": jnp.pi * n_idx + nrm(ks[7], (DEPTH, G, P), 0.01),
        "ssm_b_re": nrm(ks[8], (DEPTH, G, P, H), (2 * H) ** -0.5),
        "ssm_b_im": nrm(ks[9], (DEPTH, G, P, H), (2 * H) ** -0.5),
        "ssm_c_re": nrm(ks[10], (DEPTH, G, H, P), (2 * P) ** -0.5),
        "ssm_c_im": nrm(ks[11], (DEPTH, G, H, P), (2 * P) ** -0.5),
        "ssm_d": nrm(ks[12], (DEPTH, SSM_WIDTH), 1.0),
        "ssm_log_dt": jax.random.uniform(ks[13], (DEPTH, G), f32, math.log(DT_MIN), math.log(DT_MAX)),
        "ssm_w_glu": nrm(ks[14], (DEPTH, SSM_WIDTH, SSM_WIDTH), SSM_WIDTH ** -0.5),
        "diff_lambda_q1": nrm(ks[15], (DEPTH, DIFF_QK_DIM), 0.1),
        "diff_lambda_k1": nrm(ks[16], (DEPTH, DIFF_QK_DIM), 0.1),
        "diff_lambda_q2": nrm(ks[17], (DEPTH, DIFF_QK_DIM), 0.1),
        "diff_lambda_k2": nrm(ks[18], (DEPTH, DIFF_QK_DIM), 0.1),
        "diff_subln_g": 1.0 + nrm(ks[19], (DEPTH, DIFF_V_DIM), 0.02),
        "w_out": nrm(ks[20], (DEPTH, MIX_WIDTH, D_MODEL), MIX_WIDTH ** -0.5),
        "router_group_w": nrm(ks[21], (DEPTH, D_MODEL, N_EXPERT_GROUPS), D_MODEL ** -0.5),
        "router_group_b": nrm(ks[22], (DEPTH, N_EXPERT_GROUPS), 0.01),
        "router_expert_w": nrm(ks[23], (DEPTH, D_MODEL, N_EXPERTS), D_MODEL ** -0.5),
        "router_expert_b": nrm(ks[24], (DEPTH, N_EXPERTS), 0.01),
        "moe_w_gate": nrm(ks[25], (DEPTH, N_EXPERTS, D_MODEL, D_EXPERT), D_MODEL ** -0.5),
        "moe_w_up": nrm(ks[26], (DEPTH, N_EXPERTS, D_MODEL, D_EXPERT), D_MODEL ** -0.5),
        "moe_w_down": nrm(ks[27], (DEPTH, N_EXPERTS, D_EXPERT, D_MODEL), D_EXPERT ** -0.5),
        "final_norm_g": 1.0 + nrm(ks[28], (D_MODEL,), 0.02),
    }


def reference(x, meta_tokens, attn_norm_g, ffn_norm_g, w_in, swa_sinks, ssm_lambda_re, ssm_lambda_im,
              ssm_b_re, ssm_b_im, ssm_c_re, ssm_c_im, ssm_d, ssm_log_dt, ssm_w_glu, diff_lambda_q1,
              diff_lambda_k1, diff_lambda_q2, diff_lambda_k2, diff_subln_g, w_out, router_group_w,
              router_group_b, router_expert_w, router_expert_b, moe_w_gate, moe_w_up, moe_w_down,
              final_norm_g):
    b, _, d = x.shape
    meta = jnp.broadcast_to(meta_tokens[None].astype(x.dtype), (b, N_META, d))
    h = jnp.concatenate([meta, x], axis=1)
    pos = jnp.arange(h.shape[1], dtype=jnp.int32)
    for l in range(DEPTH):
        h = h + hybrid_mixer(rms_norm(h, attn_norm_g[l]), pos, l, w_in[l], swa_sinks[l],
                             ssm_lambda_re[l], ssm_lambda_im[l], ssm_b_re[l], ssm_b_im[l],
                             ssm_c_re[l], ssm_c_im[l], ssm_d[l], ssm_log_dt[l], ssm_w_glu[l],
                             diff_lambda_q1[l], diff_lambda_k1[l], diff_lambda_q2[l], diff_lambda_k2[l],
                             diff_subln_g[l], w_out[l])
        hn = rms_norm(h, ffn_norm_g[l]).reshape(-1, d)
        h = h + hierarchical_moe(hn, router_group_w[l], router_group_b[l], router_expert_w[l],
                                 router_expert_b[l], moe_w_gate[l], moe_w_up[l],
                                 moe_w_down[l]).reshape(h.shape)
    return rms_norm(h, final_norm_g)[:, N_META:]
```

```cpp
#include <hip/hip_runtime.h>
#include <hip/hip_cooperative_groups.h>
#include <cstdio>
#include <cstdint>
namespace cg = cooperative_groups;

constexpr int D = 2048, NBATCH = 4, SEQ = 2048, NMETA = 16, LT = SEQ + NMETA, NTOK = NBATCH * LT;
constexpr int INW = 3584;
constexpr int OFF_QA = 0, OFF_KA = 768, OFF_VA = 1024, OFF_US = 1280, OFF_QD = 2048, OFF_KD = 2560, OFF_VD = 3072;
constexpr int SSM_W = 768, SSM_G = 48, SSM_P = 64, SSM_H = 16;
constexpr int NEXP = 32, DEXP = 512, NASG = NTOK * 2;
constexpr float EPS = 1e-5f;
constexpr int NT = 512, NWV = NT / 64;

typedef unsigned short bf16_t;
typedef short bf16x8 __attribute__((ext_vector_type(8)));
typedef float f32x16 __attribute__((ext_vector_type(16)));
typedef float f32x4 __attribute__((ext_vector_type(4)));
typedef float f32x2 __attribute__((ext_vector_type(2)));
typedef unsigned u32x4 __attribute__((ext_vector_type(4)));
typedef unsigned u32x2 __attribute__((ext_vector_type(2)));
typedef __bf16 bf16x2_t __attribute__((ext_vector_type(2)));

struct P {
    const float *x, *meta, *attn_g, *ffn_g, *w_in, *sinks, *lam_re, *lam_im, *b_re, *b_im, *c_re, *c_im, *dskip, *log_dt, *w_glu,
        *lq1, *lk1, *lq2, *lk2, *subln_g, *w_out, *rg_w, *rg_b, *re_w, *re_b, *wg, *wu, *wd, *final_g;
    float* out;
    unsigned char* ws;
};

typedef const P __attribute__((address_space(4))) KP;
__device__ __forceinline__ KP* kargs() { unsigned long long k = (unsigned long long)__builtin_amdgcn_kernarg_segment_ptr(); asm volatile("" : "+s"(k)); return (KP*)k; }

constexpr size_t WS_H = 0;
constexpr size_t WS_XN = WS_H + (size_t)NTOK * D * 4;
constexpr size_t WS_QKV = WS_XN + (size_t)NTOK * D * 2;
constexpr size_t WS_MIX = WS_QKV + (size_t)NTOK * INW * 2;
constexpr size_t WS_YB = WS_MIX + (size_t)NTOK * D * 2;
constexpr size_t WS_G = WS_YB + (size_t)NTOK * SSM_W * 2;
constexpr size_t WS_Y = WS_G + (size_t)NASG * DEXP * 2;
constexpr size_t WS_SELW = WS_Y + (size_t)NASG * D * 2;
constexpr size_t WS_LIST = WS_SELW + (size_t)NASG * 4;
constexpr size_t WS_CNT = WS_LIST + (size_t)NEXP * NTOK * 4;
constexpr size_t WS_ROPE = WS_CNT + 256;
constexpr int NKT = 65;
constexpr size_t WS_KFA = WS_ROPE + (size_t)LT * 32 * 8;
constexpr size_t WS_KFD = WS_KFA + (size_t)NBATCH * 4 * NKT * 2048 * 2;
constexpr size_t WS_VTA = WS_KFD + (size_t)NBATCH * 8 * NKT * 2048 * 2;
constexpr size_t WS_VTD = WS_VTA + (size_t)NBATCH * 4 * NKT * 2048 * 2;
constexpr size_t WS_DTMP = WS_VTD + (size_t)NBATCH * 4 * NKT * 4096 * 2;
constexpr size_t WS_SSMS = WS_DTMP + (size_t)NTOK * 1024 * 2;
constexpr size_t WS_BAR = WS_SSMS + (size_t)NBATCH * SSM_G * 8 * 128 * 4;
constexpr size_t WS_BTIN = WS_BAR + 16384;
constexpr size_t WS_BTOUT = WS_BTIN + (size_t)2 * INW * D * 2;
constexpr size_t WS_RT = WS_BTOUT + (size_t)2 * D * D * 2;
constexpr size_t WS_SSMT = WS_RT + (size_t)2 * 2 * 36 * D * 2;
constexpr size_t WS_ZERO = WS_SSMT + (size_t)3 * 2 * SSM_G * SSM_P * 16;
constexpr int DEP_RDY = 256, DEP_RT = 256 + 32 * 72, DEP_LO = DEP_RT + 32, DEP_MX = DEP_RT + 64, DEP_LAYER = DEP_RT + 128;
constexpr size_t WS_DEP = WS_ZERO + 4096;
constexpr size_t WS_END = WS_DEP + (size_t)2 * DEP_LAYER * 4;

__device__ __forceinline__ float bf2f(bf16_t v) { return __uint_as_float((unsigned)v << 16); }
__device__ __forceinline__ unsigned pk2(float a, float b) { f32x2 v = {a, b}; bf16x2_t r = __builtin_convertvector(v, bf16x2_t); return *(unsigned*)&r; }
__device__ __forceinline__ bf16_t f2bf(float a) { return (bf16_t)(pk2(a, 0.f) & 0xffffu); }
template <int CTRL> __device__ __forceinline__ float dppx(float v) { return __uint_as_float(__builtin_amdgcn_mov_dpp(__float_as_uint(v), CTRL, 0xF, 0xF, true)); }
__device__ __forceinline__ float wave_sum(float v) {
    v += dppx<0xB1>(v); v += dppx<0x4E>(v); v += dppx<0x141>(v); v += dppx<0x140>(v);
    v += __int_as_float(__builtin_amdgcn_ds_swizzle(__float_as_int(v), 0x401F));
    const auto r = __builtin_amdgcn_permlane32_swap(__float_as_uint(v), __float_as_uint(v), false, false);
    return __uint_as_float(r[0]) + __uint_as_float(r[1]);
}
__device__ __forceinline__ float wave_max(float v) {
    v = fmaxf(v, dppx<0xB1>(v)); v = fmaxf(v, dppx<0x4E>(v)); v = fmaxf(v, dppx<0x141>(v)); v = fmaxf(v, dppx<0x140>(v));
    v = fmaxf(v, __int_as_float(__builtin_amdgcn_ds_swizzle(__float_as_int(v), 0x401F)));
    const auto r = __builtin_amdgcn_permlane32_swap(__float_as_uint(v), __float_as_uint(v), false, false);
    return fmaxf(__uint_as_float(r[0]), __uint_as_float(r[1]));
}

__device__ __forceinline__ int tid_opaque() { int t = threadIdx.x; asm volatile("" : "+v"(t)); return t; }
__device__ __forceinline__ float xchg32(float v) {
    const auto r = __builtin_amdgcn_permlane32_swap(__float_as_uint(v), __float_as_uint(v), false, false);
    return __uint_as_float((tid_opaque() & 32) ? r[0] : r[1]);
}
__device__ __forceinline__ int xchg32i(int v) {
    const auto r = __builtin_amdgcn_permlane32_swap((unsigned)v, (unsigned)v, false, false);
    return (int)((tid_opaque() & 32) ? r[0] : r[1]);
}
__device__ __forceinline__ void quad_transpose(float& v0, float& v1, float& v2, float& v3, int lane) {
    const bool o1 = lane & 1, o2 = lane & 2;
    float s01 = o1 ? v0 : v1, s23 = o1 ? v2 : v3;
    float r01 = __uint_as_float(__builtin_amdgcn_mov_dpp(__float_as_uint(s01), 0xB1, 0xF, 0xF, true));
    float r23 = __uint_as_float(__builtin_amdgcn_mov_dpp(__float_as_uint(s23), 0xB1, 0xF, 0xF, true));
    if (o1) { v0 = r01; v2 = r23; } else { v1 = r01; v3 = r23; }
    float s02 = o2 ? v0 : v2, s13 = o2 ? v1 : v3;
    float r02 = __uint_as_float(__builtin_amdgcn_mov_dpp(__float_as_uint(s02), 0x4E, 0xF, 0xF, true));
    float r13 = __uint_as_float(__builtin_amdgcn_mov_dpp(__float_as_uint(s13), 0x4E, 0xF, 0xF, true));
    if (o2) { v0 = r02; v1 = r13; } else { v2 = r02; v3 = r13; }
}


#define XB_TMO      128
#define XB_XCNT(j)  (256  + 64 * (j))
#define XB_XSUB(j)  (1280 + 64 * (j))
#define XB_XGEN(j)  (2304 + 64 * (j))
#define XB_TOP      3328
#define XB_TOPGEN   3392
#define XCD_BAR_WORDS 3456
#define XB_SPIN_CAP (1u << 20)
#define LAS __attribute__((address_space(3)))
__device__ __forceinline__ unsigned xb_ld(unsigned* p)              { return __hip_atomic_load(p, __ATOMIC_RELAXED, __HIP_MEMORY_SCOPE_AGENT); }
__device__ __forceinline__ unsigned xb_add(unsigned* p, unsigned v) { return __hip_atomic_fetch_add(p, v, __ATOMIC_RELAXED, __HIP_MEMORY_SCOPE_AGENT); }
__device__ __forceinline__ unsigned xb_xcc_id() { return (unsigned)__builtin_amdgcn_s_getreg((3 << 11) | 20) & 0xFu; }
#define XB_SPIN(cond, bar) do { unsigned _sp = 0; while (cond) { __builtin_amdgcn_s_sleep(1); \
    if ((++_sp & 255u) == 0u) { if (xb_ld(&(bar)[XB_TMO])) break; if (_sp > XB_SPIN_CAP) { atomicAdd(&(bar)[XB_TMO], 1u); break; } } } } while (0)
struct XcdBarrier { unsigned* bar; unsigned x; volatile LAS unsigned* st; };
__device__ __forceinline__ XcdBarrier xcd_barrier_post(unsigned* bar, volatile LAS unsigned* st) {
    XcdBarrier b; b.bar = bar; b.x = xb_xcc_id(); b.st = st;
    if (threadIdx.x == 0) (void)xb_add(&bar[XB_XCNT(b.x)], 1u);
    return b;
}
__device__ __forceinline__ void xcd_barrier_complete(unsigned* bar, unsigned x, unsigned& nloc, unsigned& nx) {
    const unsigned G = gridDim.x * gridDim.y * gridDim.z;
    unsigned sum, cnt, mine, sp = 0u;
    for (;;) {
        sum = 0u; cnt = 0u; mine = 0u;
#pragma unroll
        for (unsigned j = 0; j < 16; ++j) { const unsigned c = xb_ld(&bar[XB_XCNT(j)]); sum += c; cnt += (c > 0u) ? 1u : 0u; mine = (j == x) ? c : mine; }
        if (sum == G) break;
        __builtin_amdgcn_s_sleep(1);
        if ((++sp & 255u) == 0u) { if (xb_ld(&bar[XB_TMO])) break; if (sp > XB_SPIN_CAP) { atomicAdd(&bar[XB_TMO], 1u); break; } }
    }
    nloc = mine > 0u ? mine : 1u; nx = cnt > 0u ? cnt : 1u;
}
__device__ __forceinline__ void xcd_barrier(const XcdBarrier& b) {
    asm volatile("s_waitcnt vmcnt(0)" ::: "memory");
    __syncthreads();
    if (threadIdx.x == 0) {
        unsigned* bar = b.bar;
        __builtin_amdgcn_s_waitcnt(0);
        unsigned nloc = b.st[0], nx = b.st[1];
        if (nloc == 0u) { xcd_barrier_complete(bar, b.x, nloc, nx); b.st[0] = nloc; b.st[1] = nx; }
        const unsigned old = xb_add(&bar[XB_XSUB(b.x)], 1u);
        const unsigned gen = old / nloc;
        if (old + 1u == (gen + 1u) * nloc) {
            __builtin_amdgcn_fence(__ATOMIC_RELEASE, "agent");
            asm volatile("s_waitcnt vmcnt(0)" ::: "memory");
            const unsigned og = xb_add(&bar[XB_TOP], 1u);
            const unsigned tg = og / nx;
            if (og + 1u == (tg + 1u) * nx) xb_add(&bar[XB_TOPGEN], 1u);
            else XB_SPIN(xb_ld(&bar[XB_TOPGEN]) == tg, bar);
            __builtin_amdgcn_fence(__ATOMIC_ACQUIRE, "agent");
            xb_add(&bar[XB_XGEN(b.x)], 1u);
            asm volatile("s_waitcnt vmcnt(0)" ::: "memory");
        } else {
            XB_SPIN(xb_ld(&bar[XB_XGEN(b.x)]) == gen, bar);
            __builtin_amdgcn_fence(__ATOMIC_ACQUIRE, "agent");
            asm volatile("s_waitcnt vmcnt(0)" ::: "memory");
        }
    }
    __syncthreads();
}

constexpr int MPG8 = 8192;
constexpr int BM = 128, BN = 256, BK = 64;
constexpr int A_STAGE = BM * 128, B_STAGE = BN * 128, STAGE = A_STAGE + B_STAGE;
constexpr int LDS_ROWA = 131072;
constexpr int LDS_PRE = LDS_ROWA + 512;
constexpr int LDS_SX = LDS_PRE + 256;
constexpr int LDS_XB = LDS_SX + NWV * 128 * 4;
constexpr int LDS_BYTES = LDS_XB + 16;

__device__ __forceinline__ int swz(int r, int s) { return r * 128 + ((s ^ (((r >> 1) & 7) ^ ((r >> 4) & 1))) << 4); }

constexpr int GD_A_STAGE = 16384, GD_B_BASE = 32768, GD_B_HALF = 32768;
__device__ __forceinline__ void gemm_dual(unsigned char* lds, const bf16_t* ap0, const bf16_t* ap1, const float* bp, int ldb, int K, f32x16 (&acc)[2][2],
                                          f32x4 (&rb)[2][8], bool bpre, const float* bnext, int ldbn = 0) {
    const int tid = tid_opaque(), lane = tid & 63, th = tid & 255, wave = (tid >> 6) & 3, wm = wave >> 1, wn = wave & 1;
    const int hsel = __builtin_amdgcn_readfirstlane(tid >> 8);
#pragma unroll
    for (int i = 0; i < 2; ++i)
#pragma unroll
        for (int j = 0; j < 2; ++j)
#pragma unroll
            for (int r = 0; r < 16; ++r) acc[i][j][r] = 0.f;
    unsigned char* bst0 = lds + GD_B_BASE + hsel * GD_B_HALF; unsigned char* bst1 = bst0 + 16384;
    const int as = th & 7, arow = 64 * hsel + (th >> 3);
    const int awo0 = swz(arow, as), awo1 = swz(arow + 32, as);
    const int ng = th & 31, kg = th >> 5;
    const int bwo0 = swz(4 * ng + 0, kg), bwo1 = swz(4 * ng + 1, kg), bwo2 = swz(4 * ng + 2, kg), bwo3 = swz(4 * ng + 3, kg);
    const int r31 = lane & 31, hh = lane >> 5;
    const int cl = (hh ^ (((r31 >> 1) & 7) ^ ((r31 >> 4) & 1))) << 4;
    const int aro = (wm * 64 + r31) * 128, bro = (wn * 64 + r31) * 128;
    if (ldbn == 0) ldbn = ldb;
    const float* bpk = bp + (size_t)(kg * 8) * ldb;
    const float* bnk = bnext + (size_t)(kg * 8) * ldbn;
    const bf16_t* a0p = ap0 + as * 8; const bf16_t* a1p = ap1 + as * 8;
    u32x4 ra[2][2];
    const int KT = K / BK;
#define GD_LOADA(S, kt)                                                                            \
    {                                                                                              \
        const int ta = (kt) + hsel < KT ? (kt) + hsel : KT - 1;                                    \
        ra[S][0] = *(const u32x4*)(a0p + ta * BK);                                                 \
        ra[S][1] = *(const u32x4*)(a1p + ta * BK);                                                 \
    }
#define GD_LOADB(S, bq_, ld_)                                                                      \
    {                                                                                              \
        const float* bq = (bq_); const int ld = (ld_);                                             \
        _Pragma("unroll") for (int q = 0; q < 8; ++q) rb[S][q] = *(const f32x4*)(bq + (size_t)q * ld); \
    }
#define GD_LOADBP(S, bq, ld, q0, q1)                                                               \
    { _Pragma("unroll") for (int q = (q0); q < (q1); ++q) rb[S][q] = *(const f32x4*)((bq) + (size_t)q * (ld)); }
#define GD_STORE(S, bst)                                                                           \
    {                                                                                              \
        unsigned char* ast = lds + (((S) + hsel) & 1) * GD_A_STAGE;                                \
        *(u32x4*)(ast + awo0) = ra[S][0]; *(u32x4*)(ast + awo1) = ra[S][1];                        \
        u32x4 w0 = {pk2(rb[S][0][0], rb[S][1][0]), pk2(rb[S][2][0], rb[S][3][0]), pk2(rb[S][4][0], rb[S][5][0]), pk2(rb[S][6][0], rb[S][7][0])}; \
        u32x4 w1 = {pk2(rb[S][0][1], rb[S][1][1]), pk2(rb[S][2][1], rb[S][3][1]), pk2(rb[S][4][1], rb[S][5][1]), pk2(rb[S][6][1], rb[S][7][1])}; \
        u32x4 w2 = {pk2(rb[S][0][2], rb[S][1][2]), pk2(rb[S][2][2], rb[S][3][2]), pk2(rb[S][4][2], rb[S][5][2]), pk2(rb[S][6][2], rb[S][7][2])}; \
        u32x4 w3 = {pk2(rb[S][0][3], rb[S][1][3]), pk2(rb[S][2][3], rb[S][3][3]), pk2(rb[S][4][3], rb[S][5][3]), pk2(rb[S][6][3], rb[S][7][3])}; \
        *(u32x4*)((bst) + bwo0) = w0; *(u32x4*)((bst) + bwo1) = w1; *(u32x4*)((bst) + bwo2) = w2; *(u32x4*)((bst) + bwo3) = w3; \
    }
#define GD_LDF(ast, bst, kk, A0, A1, B0, B1)                                                        \
    { const int so = cl ^ ((kk) << 5);                                                             \
      A0 = *(const bf16x8*)((ast) + aro + so); A1 = *(const bf16x8*)((ast) + aro + 4096 + so);     \
      B0 = *(const bf16x8*)((bst) + bro + so); B1 = *(const bf16x8*)((bst) + bro + 4096 + so); }
#define GD_MF(A0, A1, B0, B1)                                                                       \
    { acc[0][0] = __builtin_amdgcn_mfma_f32_32x32x16_bf16(A0, B0, acc[0][0], 0, 0, 0);              \
      acc[0][1] = __builtin_amdgcn_mfma_f32_32x32x16_bf16(A0, B1, acc[0][1], 0, 0, 0);              \
      acc[1][0] = __builtin_amdgcn_mfma_f32_32x32x16_bf16(A1, B0, acc[1][0], 0, 0, 0);              \
      acc[1][1] = __builtin_amdgcn_mfma_f32_32x32x16_bf16(A1, B1, acc[1][1], 0, 0, 0); }
#define GD_MMA(ast, bst)                                                                           \
    { bf16x8 xa0, xa1, xb0, xb1, ya0, ya1, yb0, yb1;                                               \
      GD_LDF(ast, bst, 0, xa0, xa1, xb0, xb1); GD_LDF(ast, bst, 1, ya0, ya1, yb0, yb1); __builtin_amdgcn_sched_barrier(0); \
      GD_MF(xa0, xa1, xb0, xb1); __builtin_amdgcn_sched_barrier(0);                                \
      GD_LDF(ast, bst, 2, xa0, xa1, xb0, xb1); __builtin_amdgcn_sched_barrier(0);                  \
      GD_MF(ya0, ya1, yb0, yb1); __builtin_amdgcn_sched_barrier(0);                                \
      GD_LDF(ast, bst, 3, ya0, ya1, yb0, yb1); __builtin_amdgcn_sched_barrier(0);                  \
      GD_MF(xa0, xa1, xb0, xb1); GD_MF(ya0, ya1, yb0, yb1); }
#define GD_MMA_IL(ast, bst, S, kta, bq_, ld_)                                                      \
    { bf16x8 xa0, xa1, xb0, xb1, ya0, ya1, yb0, yb1;                                               \
      const float* bq = (bq_); const int ld = (ld_);                                               \
      GD_LDF(ast, bst, 0, xa0, xa1, xb0, xb1); GD_LDF(ast, bst, 1, ya0, ya1, yb0, yb1); __builtin_amdgcn_sched_barrier(0); \
      GD_LOADA(S, kta); __builtin_amdgcn_sched_barrier(0);                                         \
      GD_MF(xa0, xa1, xb0, xb1); __builtin_amdgcn_sched_barrier(0);                                \
      GD_LDF(ast, bst, 2, xa0, xa1, xb0, xb1); GD_LOADBP(S, bq, ld, 4, 6); __builtin_amdgcn_sched_barrier(0); \
      GD_MF(ya0, ya1, yb0, yb1); __builtin_amdgcn_sched_barrier(0);                                \
      GD_LDF(ast, bst, 3, ya0, ya1, yb0, yb1); GD_LOADBP(S, bq, ld, 6, 8); __builtin_amdgcn_sched_barrier(0); \
      GD_MF(xa0, xa1, xb0, xb1); __builtin_amdgcn_sched_barrier(0);                                \
      GD_MF(ya0, ya1, yb0, yb1); }
#define GD_SB __builtin_amdgcn_sched_barrier(0)
#define GD_SLOT_END GD_SB; __syncthreads(); GD_SB
    u32x4 e0 = {0u, 0u, 0u, 0u}, e1 = {0u, 0u, 0u, 0u};
    if (hsel == 1) { e0 = *(const u32x4*)a0p; e1 = *(const u32x4*)a1p; }
    GD_SB;
    if (!bpre) { GD_LOADB(0, bpk, ldb); GD_LOADB(1, bpk + (size_t)BK * ldb, ldb); }
    GD_LOADA(0, 0);
    GD_LOADA(1, 1);
    GD_SB;
    if (hsel == 1) {
        *(u32x4*)(lds + awo0) = e0; *(u32x4*)(lds + awo1) = e1;
        __builtin_amdgcn_s_waitcnt(0xc07f);
        __builtin_amdgcn_s_barrier();
    }
    GD_SB;
    GD_STORE(0, bst0);
    GD_SB; GD_LOADBP(0, (2 < KT ? bpk + (size_t)2 * BK * ldb : bnk), (2 < KT ? ldb : ldbn), 0, 4);
    GD_SLOT_END;
    for (int kt = 0; kt < KT; kt += 2) {
        GD_MMA_IL(lds, bst0, 0, (kt + 2 < KT ? kt + 2 : KT - 2), (kt + 2 < KT ? bpk + (size_t)(kt + 2) * BK * ldb : bnk), (kt + 2 < KT ? ldb : ldbn));
        GD_SLOT_END;
        GD_STORE(1, bst1);
        GD_SB; GD_LOADBP(1, (kt + 3 < KT ? bpk + (size_t)(kt + 3) * BK * ldb : bnk + (size_t)BK * ldbn), (kt + 3 < KT ? ldb : ldbn), 0, 4);
        GD_SLOT_END;
        GD_MMA_IL(lds + GD_A_STAGE, bst1, 1, (kt + 3 < KT ? kt + 3 : KT - 1), (kt + 3 < KT ? bpk + (size_t)(kt + 3) * BK * ldb : bnk + (size_t)BK * ldbn), (kt + 3 < KT ? ldb : ldbn));
        GD_SLOT_END;
        if (kt + 2 < KT) GD_STORE(0, bst0);
        GD_SB; GD_LOADBP(0, (kt + 4 < KT ? bpk + (size_t)(kt + 4) * BK * ldb : bnk), (kt + 4 < KT ? ldb : ldbn), 0, 4);
        GD_SLOT_END;
    }
    if (hsel == 0) __builtin_amdgcn_s_barrier();
    GD_SB;
#undef GD_LOADA
#undef GD_LOADB
#undef GD_STORE
#undef GD_MMA
#undef GD_MMA_IL
#undef GD_LOADBP
#undef GD_LDF
#undef GD_MF
#undef GD_SB
#undef GD_SLOT_END
}


namespace pg8 {
#define PG8_LAS __attribute__((address_space(3)))
typedef unsigned short bf16_t;
typedef short bf16x8 __attribute__((ext_vector_type(8)));
typedef float f32x4 __attribute__((ext_vector_type(4)));
typedef unsigned u32x4 __attribute__((ext_vector_type(4)));
constexpr int BM = 256, BK = 64, HALF = 128, HTB = HALF * BK * 2  , STAGE_BYTES = 8 * HTB, NXCD = 8, WGM = 8;

__host__ __device__ __forceinline__ int lds_byte(int r, int c) { const int st = (r >> 4) * 2 + (c >> 5), rr = r & 15, cc = c & 31, ob = rr * 64 + cc * 2; return st * 1024 + (ob ^ (((ob >> 9) & 1) << 5)); }
__host__ __device__ __forceinline__ void stage_rc(int b, int& R, int& C) { const int st = b / 1024, sb = b % 1024, swz = sb ^ (((sb >> 9) & 1) << 5); R = (st >> 1) * 16 + swz / 64; C = (st & 1) * 32 + (swz % 64) / 2; }
__host__ __device__ __forceinline__ int perm32(int rho) { const int n = rho >> 4, i = rho & 15; return 8 * (i >> 2) + 4 * n + (i & 3); }

struct Unit { int pm, pn; };
struct Gemm { const bf16_t* A; const bf16_t* Bt; int M, N, K; };

struct StaticOrder {
    int nM, nN, nwg, G, c;
    __host__ __device__ void init(int M, int N, int G_, int c_) { nM = M / BM; nN = N / BM; nwg = nM * nN; G = G_; c = c_; }
    __host__ __device__ bool next(int i, Unit& u) const {
        const long L = (long)i * G + c; if (L >= nwg) return false;
        int wgid = (int)L; { const int q = nwg / NXCD, r = nwg % NXCD, xcd = wgid % NXCD, off = wgid / NXCD; wgid = (xcd < r ? xcd * (q + 1) : r * (q + 1) + (xcd - r) * q) + off; }
        const int nig = WGM * nN, gid = wgid / nig, fm = gid * WGM, gsz = (nM - fm) < WGM ? (nM - fm) : WGM;
        u.pm = fm + ((wgid % nig) % gsz); u.pn = (wgid % nig) / gsz; return true;
    }
    __device__ __forceinline__ void a_ready(const Unit&) const {}
    __device__ __forceinline__ void done(const Unit&) const {}
};

template <class Epi, class Sched, bool ALIGN_EPI = false, bool SP2 = false>
__device__ __forceinline__ void gemm_phase(PG8_LAS unsigned char* lds, const Gemm g, const Sched& S, const Epi& E) {
    const int tid = tid_opaque(), wid = __builtin_amdgcn_readfirstlane(tid >> 6), lane = tid & 63, wr = wid >> 2, wc = wid & 3, fr = lane & 15, fq = lane >> 4;
    const int K = g.K, nt = K / BK;
    unsigned voffA[2], voffB[2];
#pragma unroll
    for (int i = 0; i < 2; ++i) { int R, C; stage_rc(tid * 16 + i * 8192, R, C); const int Rb = Epi::PERM ? ((R & ~31) + perm32(R & 31)) : R;
        voffA[i] = (unsigned)(R * K + C) * 2u; voffB[i] = (unsigned)(Rb * K + C) * 2u; }
    const size_t kstep = (size_t)(BK * 2);
    const size_t hstep = (size_t)HALF * K * 2;
    const size_t tstep = 2 * hstep;
    const unsigned ldsw = (unsigned)wid * 1024u;
    const int aoff = lds_byte(wr * 64 + fr, fq * 8), boff = lds_byte(wc * 32 + fr, fq * 8);
#define PG8_SA(b, h) (((b) * 2 + (h)) * HTB)
#define PG8_SB(b, h) ((4 + (b) * 2 + (h)) * HTB)
#define PG8_STAGE(bufoff, gbase, voff) do { _Pragma("unroll") for (int _i = 0; _i < 2; ++_i) \
        __builtin_amdgcn_global_load_lds((const unsigned*)((const char*)(gbase) + (voff)[_i]), (PG8_LAS unsigned*)(lds + (bufoff) + ldsw + _i * 8192), 16, 0, 0); } while (0)
#define PG8_LDA(dst, b, h) do { _Pragma("unroll") for (int m = 0; m < 4; ++m) _Pragma("unroll") for (int k = 0; k < 2; ++k) dst[m][k] = *(const PG8_LAS bf16x8*)(lds + PG8_SA(b, h) + aoff + m * 2048 + k * 1024); } while (0)
#define PG8_LDB(dst, b, h) do { _Pragma("unroll") for (int n = 0; n < 2; ++n) _Pragma("unroll") for (int k = 0; k < 2; ++k) dst[n][k] = *(const PG8_LAS bf16x8*)(lds + PG8_SB(b, h) + boff + n * 2048 + k * 1024); } while (0)
#define PG8_MMA(ai, bj, At, Bt) do { __builtin_amdgcn_s_setprio(1); _Pragma("unroll") for (int m = 0; m < 4; ++m) _Pragma("unroll") for (int n = 0; n < 2; ++n) _Pragma("unroll") for (int k = 0; k < 2; ++k) \
        acc[ai][bj][m][n] = __builtin_amdgcn_mfma_f32_16x16x32_bf16(Bt[n][k], At[m][k], acc[ai][bj][m][n], 0, 0, 0); __builtin_amdgcn_s_setprio(0); } while (0)
#define PG8_WAIT_V(n) asm volatile("s_waitcnt vmcnt(" #n ")" ::: "memory")
#define PG8_WAIT_L(n) asm volatile("s_waitcnt lgkmcnt(" #n ")" ::: "memory")
#define PG8_BAR __builtin_amdgcn_s_barrier()
#define PG8_SCHED __builtin_amdgcn_sched_barrier(0)
    Unit cur, nxt; int ui = 0;
    if (!S.next(0, cur)) return;
    f32x4 acc[2][2][4][2];
#pragma unroll
    for (int a = 0; a < 2; ++a)
#pragma unroll
        for (int b = 0; b < 2; ++b)
#pragma unroll
            for (int m = 0; m < 4; ++m)
#pragma unroll
                for (int n = 0; n < 2; ++n) acc[a][b][m][n] = (f32x4){0.f, 0.f, 0.f, 0.f};
    bf16x8 At[4][2], B0[2][2], B1[2][2];
    const char* cA = (const char*)g.A + (size_t)cur.pm * tstep; const char* cB = (const char*)g.Bt + (size_t)cur.pn * tstep;
    S.a_ready(cur);
    if constexpr (SP2) {
        PG8_STAGE(PG8_SB(0, 0), cB, voffB); PG8_STAGE(PG8_SB(0, 1), cB + hstep, voffB); PG8_STAGE(PG8_SA(0, 0), cA, voffA); PG8_STAGE(PG8_SA(0, 1), cA + hstep, voffA);
        if (wr == 1) PG8_BAR;
        PG8_WAIT_V(2); PG8_BAR;
        PG8_STAGE(PG8_SB(1, 0), cB + kstep, voffB); PG8_STAGE(PG8_SA(1, 0), cA + kstep, voffA); PG8_STAGE(PG8_SB(1, 1), cB + hstep + kstep, voffB);
        PG8_WAIT_V(6); PG8_BAR;
    } else {
        PG8_STAGE(PG8_SB(0, 0), cB, voffB); PG8_STAGE(PG8_SA(0, 0), cA, voffA); PG8_STAGE(PG8_SB(0, 1), cB + hstep, voffB); PG8_STAGE(PG8_SA(0, 1), cA + hstep, voffA);
        if (wr == 1) PG8_BAR;
        PG8_WAIT_V(4); PG8_BAR;
        PG8_STAGE(PG8_SB(1, 0), cB + kstep, voffB); PG8_STAGE(PG8_SA(1, 0), cA + kstep, voffA); PG8_STAGE(PG8_SB(1, 1), cB + hstep + kstep, voffB);
        PG8_WAIT_V(6); PG8_BAR;
    }
    for (;;) {
        const bool has_next = S.next(ui + 1, nxt);
        const char* nA = has_next ? (const char*)g.A + (size_t)nxt.pm * tstep : cA; const char* nB = has_next ? (const char*)g.Bt + (size_t)nxt.pn * tstep : cB;
        for (int t = 0; t < nt; t += 2) {
            const bool last = (t == nt - 2);
            const char* a1 = cA + (size_t)(t + 1) * kstep;
            const char* a2 = last ? nA : cA + (size_t)(t + 2) * kstep; const char* b2 = last ? nB : cB + (size_t)(t + 2) * kstep;
            const char* a3 = a2 + kstep; const char* b3 = b2 + kstep;
            if (last && has_next) S.a_ready(nxt);
            if constexpr (SP2) {
            PG8_LDB(B0, 0, 0); PG8_LDB(B1, 0, 1); PG8_SCHED; PG8_LDA(At, 0, 0); PG8_STAGE(PG8_SA(1, 1), a1 + hstep, voffA);
            PG8_WAIT_V(8); PG8_WAIT_L(0); PG8_BAR; PG8_MMA(0, 0, At, B0); PG8_MMA(0, 1, At, B1); PG8_BAR; PG8_SCHED;
            PG8_LDA(At, 0, 1); PG8_STAGE(PG8_SB(0, 0), b2, voffB); PG8_STAGE(PG8_SB(0, 1), b2 + hstep, voffB); PG8_STAGE(PG8_SA(0, 0), a2, voffA);
            PG8_WAIT_V(8); PG8_WAIT_L(0); PG8_BAR; PG8_MMA(1, 0, At, B0); PG8_MMA(1, 1, At, B1); PG8_BAR; PG8_SCHED;
            PG8_LDB(B0, 1, 0); PG8_LDB(B1, 1, 1); PG8_SCHED; PG8_LDA(At, 1, 0); PG8_STAGE(PG8_SA(0, 1), a2 + hstep, voffA);
            PG8_WAIT_V(8); PG8_WAIT_L(0); PG8_BAR; PG8_MMA(0, 0, At, B0); PG8_MMA(0, 1, At, B1); PG8_BAR; PG8_SCHED;
            PG8_LDA(At, 1, 1); PG8_STAGE(PG8_SB(1, 0), b3, voffB); PG8_STAGE(PG8_SB(1, 1), b3 + hstep, voffB); PG8_STAGE(PG8_SA(1, 0), a3, voffA);
            PG8_WAIT_V(8); PG8_WAIT_L(0); PG8_BAR; PG8_MMA(1, 0, At, B0); PG8_MMA(1, 1, At, B1); PG8_BAR; PG8_SCHED;
            } else {
            PG8_LDB(B0, 0, 0); PG8_SCHED; PG8_LDA(At, 0, 0); PG8_STAGE(PG8_SA(1, 1), a1 + hstep, voffA);
            PG8_WAIT_L(8); PG8_BAR; PG8_WAIT_L(0); PG8_MMA(0, 0, At, B0); PG8_BAR; PG8_SCHED;
            PG8_LDB(B1, 0, 1); PG8_STAGE(PG8_SB(0, 0), b2, voffB);
            PG8_BAR; PG8_WAIT_L(0); PG8_MMA(0, 1, At, B1); PG8_BAR;
            PG8_LDA(At, 0, 1); PG8_STAGE(PG8_SA(0, 0), a2, voffA);
            PG8_BAR; PG8_WAIT_L(0); PG8_MMA(1, 0, At, B0); PG8_BAR; PG8_SCHED;
            PG8_STAGE(PG8_SB(0, 1), b2 + hstep, voffB);
            PG8_WAIT_V(6); PG8_BAR; PG8_MMA(1, 1, At, B1); PG8_BAR;
            PG8_LDB(B0, 1, 0); PG8_SCHED; PG8_LDA(At, 1, 0); PG8_STAGE(PG8_SA(0, 1), a2 + hstep, voffA);
            PG8_WAIT_L(8); PG8_BAR; PG8_WAIT_L(0); PG8_MMA(0, 0, At, B0); PG8_BAR; PG8_SCHED;
            PG8_LDB(B1, 1, 1); PG8_STAGE(PG8_SB(1, 0), b3, voffB);
            PG8_BAR; PG8_WAIT_L(0); PG8_MMA(0, 1, At, B1); PG8_BAR;
            PG8_LDA(At, 1, 1); PG8_STAGE(PG8_SA(1, 0), a3, voffA);
            PG8_BAR; PG8_WAIT_L(0); PG8_MMA(1, 0, At, B0); PG8_BAR; PG8_SCHED;
            PG8_STAGE(PG8_SB(1, 1), b3 + hstep, voffB);
            PG8_WAIT_V(6); PG8_BAR; PG8_MMA(1, 1, At, B1); PG8_BAR;
            }
        }
        if constexpr (ALIGN_EPI) { if (wr == 0) PG8_BAR; }
        if constexpr (!Epi::AFTER_DRAIN) { E(acc, cur, wr, wc, fr, fq); S.done(cur); }
        if (!has_next) break;
#pragma unroll
        for (int a = 0; a < 2; ++a)
#pragma unroll
            for (int b = 0; b < 2; ++b)
#pragma unroll
                for (int m = 0; m < 4; ++m)
#pragma unroll
                    for (int n = 0; n < 2; ++n) acc[a][b][m][n] = (f32x4){0.f, 0.f, 0.f, 0.f};
        cur = nxt; cA = nA; cB = nB; ++ui;
        if constexpr (ALIGN_EPI) { if (wr == 1) PG8_BAR; }
    }
    PG8_WAIT_V(0);
    if constexpr (!ALIGN_EPI) { if (wr == 0) PG8_BAR; }
    PG8_BAR;
    if constexpr (Epi::AFTER_DRAIN) { E.fused(acc, cur, wr, wc, fr, fq, lds, wid, lane); S.done(cur); }
#undef PG8_SA
#undef PG8_SB
#undef PG8_STAGE
#undef PG8_LDA
#undef PG8_LDB
#undef PG8_MMA
#undef PG8_WAIT_V
#undef PG8_WAIT_L
#undef PG8_BAR
#undef PG8_SCHED
}
}

__device__ __forceinline__ int vt_pos(int k) { return (k & 3) | (((k >> 3) & 1) << 2) | (((k >> 2) & 1) << 3); }

struct EpiInProj {
    static constexpr bool PERM = false, AFTER_DRAIN = false;
    bf16_t* qkv; bf16_t* kfa; bf16_t* kfd; bf16_t* vta; bf16_t* vtd; const f32x2* rope;
    __device__ __forceinline__ void operator()(const pg8::f32x4 (&acc)[2][2][4][2], const pg8::Unit& u, int wr, int wc, int fr, int fq) const {
        const int cw = 16 * (wc & 1) + 4 * fq;
        pg8::f32x4 rc[2][4][2];
        { const int cb0 = 64 * (4 * u.pn + (wc >> 1)), cb1 = cb0 + 128;
          if (cb0 < 1024 || (cb0 >= 2048 && cb0 < 3072) || cb1 < 1024 || (cb1 >= 2048 && cb1 < 3072)) {
#pragma unroll
              for (int ai = 0; ai < 2; ++ai)
#pragma unroll
                  for (int m = 0; m < 4; ++m) {
                      const int row = 256 * u.pm + 128 * ai + 64 * wr + 16 * m + fr;
                      const pg8::f32x4* rp = (const pg8::f32x4*)(rope + (size_t)(row % LT) * 32 + cw);
                      rc[ai][m][0] = rp[0]; rc[ai][m][1] = rp[1];
                  }
          } }
#pragma unroll
        for (int bj = 0; bj < 2; ++bj) {
            const int cb = 64 * (4 * u.pn + 2 * bj + (wc >> 1));
            const bool is_rope = cb < 1024 || (cb >= 2048 && cb < 3072);
            const bool is_v = (cb >= OFF_VA && cb < OFF_US) || cb >= OFF_VD;
            const bool is_k = (cb >= OFF_KA && cb < OFF_VA) || (cb >= OFF_KD && cb < OFF_VD);
#pragma unroll
            for (int ai = 0; ai < 2; ++ai)
#pragma unroll
                for (int m = 0; m < 4; ++m) {
                    const int row = 256 * u.pm + 128 * ai + 64 * wr + 16 * m + fr;
                    if (row >= NTOK) continue;
                    pg8::f32x4 v0 = acc[ai][bj][m][0], v1 = acc[ai][bj][m][1];
                    const int b = row / LT, pos = row % LT, kt = pos >> 5;
                    if (is_v) {
                        const int s2 = (pos >> 4) & 1, qd = fr & 3, g4 = fr >> 2, hv = g4 & 1, j0 = 4 * (g4 >> 1);
                        bf16_t* dst = (cb < OFF_US) ? vta + ((((size_t)(b * 4 + (cb - OFF_VA) / 64) * NKT + kt) * 2 + 0) * 2 + s2) * 512 + (size_t)(cw + qd + 32 * hv) * 8 + j0
                                                    : vtd + ((((size_t)(b * 4 + (cb - OFF_VD) / 128) * NKT + kt) * 4 + (((cb - OFF_VD) & 127) >> 5)) * 2 + s2) * 512 + (size_t)(cw + qd + 32 * hv) * 8 + j0;
                        { float a0 = v0[0], a1 = v0[1], a2 = v0[2], a3 = v0[3]; quad_transpose(a0, a1, a2, a3, fr); *(u32x2*)dst = (u32x2){pk2(a0, a1), pk2(a2, a3)}; }
                        { float a0 = v1[0], a1 = v1[1], a2 = v1[2], a3 = v1[3]; quad_transpose(a0, a1, a2, a3, fr); *(u32x2*)(dst + 1024) = (u32x2){pk2(a0, a1), pk2(a2, a3)}; }
                    } else {
                        if (is_rope) {
                            const pg8::f32x4 c01 = rc[ai][m][0], c23 = rc[ai][m][1];
                            const float cs[4] = {c01[0], c01[2], c23[0], c23[2]}, sn[4] = {c01[1], c01[3], c23[1], c23[3]};
#pragma unroll
                            for (int e = 0; e < 4; ++e) { const float x1 = v0[e], x2 = v1[e]; v0[e] = x1 * cs[e] - x2 * sn[e]; v1[e] = x2 * cs[e] + x1 * sn[e]; }
                        }
                        const u32x2 w0 = {pk2(v0[0], v0[1]), pk2(v0[2], v0[3])}, w1 = {pk2(v1[0], v1[1]), pk2(v1[2], v1[3])};
                        if (is_k) {
                            bf16_t* kb = (cb < OFF_VA) ? kfa + ((size_t)(b * 4 + (cb - OFF_KA) / 64) * NKT + kt) * 2048 : kfd + ((size_t)(b * 8 + (cb - OFF_KD) / 64) * NKT + kt) * 2048;
                            bf16_t* kp = kb + (size_t)(cw >> 4) * 512 + (size_t)((pos & 31) + 32 * ((cw >> 3) & 1)) * 8 + (cw & 7);
                            *(u32x2*)kp = w0; *(u32x2*)(kp + 1024) = w1;
                        } else {
                            bf16_t* op = qkv + (size_t)row * INW + cb + cw;
                            *(u32x2*)op = w0; *(u32x2*)(op + 32) = w1;
                        }
                    }
                }
        }
    }
};
struct EpiOutProj {
    static constexpr bool PERM = false, AFTER_DRAIN = false;
    float* h; const float* x; const float* meta;
    const bf16_t* Y;
    __device__ __forceinline__ void operator()(const pg8::f32x4 (&acc)[2][2][4][2], const pg8::Unit& u, int wr, int wc, int fr, int fq) const {
        const __amdgpu_buffer_rsrc_t hrs = __builtin_amdgcn_make_buffer_rsrc((void*)h, 0, NTOK * D * 4, 0x00020000);
        if (Y) {
#pragma unroll
            for (int ai = 0; ai < 2; ++ai)
#pragma unroll
                for (int mp = 0; mp < 2; ++mp) {
                    pg8::f32x4 r[2][2][2]; u32x2 ya[2][2][2], yb2[2][2][2];
#pragma unroll
                    for (int mm = 0; mm < 2; ++mm) {
                        const int row = 256 * u.pm + 128 * ai + 64 * wr + 16 * (2 * mp + mm) + fr, co = 256 * u.pn + 32 * wc + 4 * fq;
                        const float* sr = h + (size_t)row * D + co; const bf16_t* y0 = Y + (size_t)(2 * row) * D + co;
#pragma unroll
                        for (int bj = 0; bj < 2; ++bj)
#pragma unroll
                            for (int n = 0; n < 2; ++n) { r[mm][bj][n] = *(const pg8::f32x4*)(sr + 128 * bj + 16 * n); ya[mm][bj][n] = *(const u32x2*)(y0 + 128 * bj + 16 * n); yb2[mm][bj][n] = *(const u32x2*)(y0 + D + 128 * bj + 16 * n); }
                    }
#pragma unroll
                    for (int mm = 0; mm < 2; ++mm) {
                        const int m = 2 * mp + mm, row = 256 * u.pm + 128 * ai + 64 * wr + 16 * m + fr, co = 256 * u.pn + 32 * wc + 4 * fq;
#pragma unroll
                        for (int bj = 0; bj < 2; ++bj)
#pragma unroll
                            for (int n = 0; n < 2; ++n) {
                                const u32x2 c0 = ya[mm][bj][n], c1 = yb2[mm][bj][n];
                                const pg8::f32x4 yv = {__uint_as_float(c0[0] << 16) + __uint_as_float(c1[0] << 16), __uint_as_float(c0[0] & 0xffff0000u) + __uint_as_float(c1[0] & 0xffff0000u),
                                                       __uint_as_float(c0[1] << 16) + __uint_as_float(c1[1] << 16), __uint_as_float(c0[1] & 0xffff0000u) + __uint_as_float(c1[1] & 0xffff0000u)};
                                const pg8::f32x4 o = (r[mm][bj][n] + yv) + acc[ai][bj][m][n];
                                __builtin_amdgcn_raw_buffer_store_b128(*(const u32x4*)&o, hrs, (unsigned)((row * D + co + 128 * bj + 16 * n) * 4), 0, 16); }
                    }
                }
            return;
        }
#pragma unroll
        for (int ai = 0; ai < 2; ++ai) {
            pg8::f32x4 r[4][2][2];
#pragma unroll
            for (int m = 0; m < 4; ++m) {
                const int row = 256 * u.pm + 128 * ai + 64 * wr + 16 * m + fr, co = 256 * u.pn + 32 * wc + 4 * fq;
                const float* sr = h + (size_t)row * D + co;
                if (x) { const int b = row / LT, i = row % LT; sr = (i < NMETA ? meta + (size_t)i * D : x + ((size_t)b * SEQ + (i - NMETA)) * D) + co; }
#pragma unroll
                for (int bj = 0; bj < 2; ++bj)
#pragma unroll
                    for (int n = 0; n < 2; ++n) r[m][bj][n] = *(const pg8::f32x4*)(sr + 128 * bj + 16 * n);
            }
#pragma unroll
            for (int m = 0; m < 4; ++m) {
                const int row = 256 * u.pm + 128 * ai + 64 * wr + 16 * m + fr, co = 256 * u.pn + 32 * wc + 4 * fq;
#pragma unroll
                for (int bj = 0; bj < 2; ++bj)
#pragma unroll
                    for (int n = 0; n < 2; ++n) { const pg8::f32x4 o = r[m][bj][n] + acc[ai][bj][m][n];
                        __builtin_amdgcn_raw_buffer_store_b128(*(const u32x4*)&o, hrs, (unsigned)((row * D + co + 128 * bj + 16 * n) * 4), 0, 16); }
            }
        }
    }
};
constexpr int MPAD = 8448;

__device__ __forceinline__ void transpose_item(const float* W, int K, int N, bf16_t* WT, bool swap45, float* scr, int item, int tid) {
    const int nblk = N / 64, kb = item / nblk, nb = item % nblk, k0 = kb * 64, n0 = nb * 64;
#pragma unroll
    for (int i = 0; i < 8; ++i) { const int r = (tid >> 6) + 8 * i, c = tid & 63; scr[r * 65 + c] = W[(size_t)(k0 + r) * N + n0 + c]; }
    __syncthreads();
    {
        const int n = tid >> 3, kc = tid & 7;
        const float* s = scr + (8 * kc) * 65 + n;
        const int np = swap45 ? ((n & 15) | ((n & 16) << 1) | ((n & 32) >> 1)) : n;
        *(u32x4*)(WT + (size_t)(n0 + np) * K + k0 + 8 * kc) = (u32x4){pk2(s[0], s[65]), pk2(s[2 * 65], s[3 * 65]), pk2(s[4 * 65], s[5 * 65]), pk2(s[6 * 65], s[7 * 65])};
    }
    __syncthreads();
}

__device__ __forceinline__ void phase_init(KP& p, int* cnt, f32x2* rope, unsigned char* lds, bf16_t* btin, bf16_t* btout, bf16_t* rtab, f32x4* ssmt, bf16_t* zrow, bf16_t* vfa_, bf16_t* vfd_) {
    if (blockIdx.x == 0 && threadIdx.x < 2 * NEXP) cnt[threadIdx.x] = 0;
    if (blockIdx.x == 1) ((unsigned long long*)zrow)[threadIdx.x] = 0ull;
    for (int e = blockIdx.x * NT + threadIdx.x; e < 2 * DEP_LAYER; e += gridDim.x * NT) ((unsigned*)(p.ws + WS_DEP))[e] = 0u;
    for (int e = blockIdx.x * NT + threadIdx.x; e < LT * 32; e += gridDim.x * NT) {
        const int j = e & 31, i = e >> 5;
        const float inv = powf(10000.0f, -(float)j / 32.0f);
        const float ang = (float)i * inv;
        rope[e] = (f32x2){cosf(ang), sinf(ang)};
    }
    for (int e = blockIdx.x * NT + threadIdx.x; e < NBATCH * 4 * (2 + 4) * 64; e += gridDim.x * NT) {
        const int lane_ = e & 63, q = e >> 6, bh = q / 6, dq = q % 6;
        bf16_t* dst = dq < 2 ? vfa_ + ((((size_t)bh * NKT + 64) * 2 + dq) * 2 + 1) * 512 + lane_ * 8 : vfd_ + ((((size_t)bh * NKT + 64) * 4 + (dq - 2)) * 2 + 1) * 512 + lane_ * 8;
        *(u32x4*)dst = (u32x4){0u, 0u, 0u, 0u};
    }
    for (int e = blockIdx.x * NT + threadIdx.x; e < 2 * SSM_G * SSM_P; e += gridDim.x * NT) {
        const float dt = expf(p.log_dt[e / SSM_P]);
        const float lr = p.lam_re[e], li = p.lam_im[e];
        const float mag = expf(lr * dt);
        const float ar = mag * cosf(li * dt), ai = mag * sinf(li * dt);
        const float den = lr * lr + li * li, nr = ar - 1.0f;
        ssmt[e] = (f32x4){ar, ai, (nr * lr + ai * li) / den, (ai * lr - nr * li) / den};
        const float a2r = ar * ar - ai * ai, a2i = 2.0f * ar * ai;
        ssmt[2 * SSM_G * SSM_P + e] = (f32x4){a2r, a2i, a2r * ar - a2i * ai, a2r * ai + a2i * ar};
        float xr = a2r * a2r - a2i * a2i, xi = 2.0f * a2r * a2i;
        const float a4r = xr, a4i = xi;
        for (int q = 0; q < 6; ++q) { const float nr2 = xr * xr - xi * xi, ni2 = 2.0f * xr * xi; xr = nr2; xi = ni2; }
        ssmt[4 * SSM_G * SSM_P + e] = (f32x4){a4r, a4i, xr, xi};
    }
    for (int e = blockIdx.x * NT + threadIdx.x; e < 2 * 36 * D; e += gridDim.x * NT) {
        const int k = e % D, c = (e / D) % 36, layer = e / (36 * D);
        const float w = (c < 32 ? p.re_w[((size_t)layer * D + k) * 32 + c] : p.rg_w[((size_t)layer * D + k) * 4 + (c - 32)]) * p.ffn_g[layer * D + k];
        const bf16_t hi = f2bf(w);
        const size_t ix = c < 32 ? (((size_t)(k >> 4) * 64 + c + 32 * ((k >> 3) & 1)) * 8 + (k & 7)) : ((size_t)c * D + k);
        rtab[(size_t)(layer * 2 + 0) * 36 * D + ix] = hi;
        rtab[(size_t)(layer * 2 + 1) * 36 * D + ix] = f2bf(w - bf2f(hi));
    }
    constexpr int I_IN = (D / 64) * (INW / 64), I_OUT = (D / 64) * (D / 64);
    const int tid = tid_opaque();
    for (int it = blockIdx.x; it < 2 * (I_IN + I_OUT); it += gridDim.x) {
        const int layer = it / (I_IN + I_OUT), r = it % (I_IN + I_OUT);
        if (r < I_IN) transpose_item(p.w_in + (size_t)layer * D * INW, D, INW, btin + (size_t)layer * INW * D, true, (float*)lds, r, tid);
        else transpose_item(p.w_out + (size_t)layer * D * D, D, D, btout + (size_t)layer * D * D, false, (float*)lds, r - I_IN, tid);
    }
}

__device__ __forceinline__ void phase_norm(KP& p, int mode, const float* g, float* h, bf16_t* xn, const bf16_t* Y) {
    const int tidq = tid_opaque(), lane = tidq & 63, gw = (blockIdx.x * NT + tidq) >> 6, nw = (gridDim.x * NT) >> 6;
    for (int t = gw; t < NTOK; t += nw) {
        const int b = t / LT, i = t % LT;
        float4 v[8];
        if (mode == 0) {
            const float* src = (i < NMETA) ? p.meta + (size_t)i * D : p.x + ((size_t)b * SEQ + (i - NMETA)) * D;
#pragma unroll
            for (int j = 0; j < 8; ++j) v[j] = *(const float4*)(src + j * 256 + lane * 4);
        } else {
            const bf16_t* y0 = Y + (size_t)(2 * t) * D; const bf16_t* y1 = y0 + D; const float* hr = h + (size_t)t * D;
#pragma unroll
            for (int j = 0; j < 8; ++j) {
                const float4 a = *(const float4*)(hr + j * 256 + lane * 4);
                const u32x2 c0 = *(const u32x2*)(y0 + j * 256 + lane * 4), c1 = *(const u32x2*)(y1 + j * 256 + lane * 4);
                v[j] = make_float4(a.x + __uint_as_float(c0[0] << 16) + __uint_as_float(c1[0] << 16), a.y + __uint_as_float(c0[0] & 0xffff0000u) + __uint_as_float(c1[0] & 0xffff0000u),
                                   a.z + __uint_as_float(c0[1] << 16) + __uint_as_float(c1[1] << 16), a.w + __uint_as_float(c0[1] & 0xffff0000u) + __uint_as_float(c1[1] & 0xffff0000u));
            }
        }
        float ss = 0.f;
#pragma unroll
        for (int j = 0; j < 8; ++j) ss += v[j].x * v[j].x + v[j].y * v[j].y + v[j].z * v[j].z + v[j].w * v[j].w;
        ss = wave_sum(ss);
        const float rs = rsqrtf(ss * (1.0f / D) + EPS);
        float4 gg8[8];
#pragma unroll
        for (int j = 0; j < 8; ++j) gg8[j] = *(const float4*)(g + j * 256 + lane * 4);
        if (mode != 2) {
            const bool wr_h = t >= MPG8;
#pragma unroll
            for (int j = 0; j < 8; ++j) {
                if (wr_h) *(float4*)(h + (size_t)t * D + j * 256 + lane * 4) = v[j];
                const float4 gg = gg8[j];
                *(u32x2*)(xn + (size_t)t * D + j * 256 + lane * 4) = (u32x2){pk2(v[j].x * rs * gg.x, v[j].y * rs * gg.y), pk2(v[j].z * rs * gg.z, v[j].w * rs * gg.w)};
            }
        } else if (i >= NMETA) {
            float* dst = p.out + ((size_t)b * SEQ + (i - NMETA)) * D;
#pragma unroll
            for (int j = 0; j < 8; ++j) {
                const float4 gg = gg8[j];
                *(float4*)(dst + j * 256 + lane * 4) = make_float4(v[j].x * rs * gg.x, v[j].y * rs * gg.y, v[j].z * rs * gg.z, v[j].w * rs * gg.w);
            }
        }
    }
}

template <int DVT, bool WINDOW>
__device__ __forceinline__ void attn_core(const bf16_t* qrow, const bf16_t* kfr, const bf16_t* vfr, int qi, int kt0, int kt1, int lane, float& m, float& l, f32x16 (&oT)[DVT]) {
    const int r31 = lane & 31, hh = lane >> 5;
    bf16x8 qf[4];
#pragma unroll
    for (int kk = 0; kk < 4; ++kk) {
        const u32x4 qv = *(const u32x4*)(qrow + kk * 16 + 8 * hh);
        u32x4 qs;
#pragma unroll
        for (int j = 0; j < 4; ++j) qs[j] = pk2(__uint_as_float(qv[j] << 16) * 0.18033688011112042f, __uint_as_float(qv[j] & 0xffff0000u) * 0.18033688011112042f);
        qf[kk] = *(bf16x8*)&qs;
    }
    m = -1e30f; l = 0.f;
#pragma unroll
    for (int dt = 0; dt < DVT; ++dt)
#pragma unroll
        for (int r = 0; r < 16; ++r) oT[dt][r] = 0.f;
    bf16x8 kfA[4], kfB[4], vfA[DVT][2], vfB[DVT][2];
#define ATT_LOAD(KF, VF, kt_)                                                                       \
    {                                                                                              \
        const bf16_t* kp = kfr + ((size_t)(kt_) * 256 + lane) * 8;                                 \
        _Pragma("unroll") for (int kk = 0; kk < 4; ++kk) KF[kk] = *(const bf16x8*)(kp + kk * 512); \
        const bf16_t* vp = vfr + ((size_t)(kt_) * (DVT * 128) + lane) * 8;                         \
        _Pragma("unroll") for (int dt = 0; dt < DVT; ++dt)                                         \
            _Pragma("unroll") for (int s2 = 0; s2 < 2; ++s2) VF[dt][s2] = *(const bf16x8*)(vp + (dt * 2 + s2) * 512); \
    }
#define ATT_TILE(KF, VF, kt_)                                                                       \
    {                                                                                              \
        f32x16 s;                                                                                  \
        _Pragma("unroll") for (int r = 0; r < 16; ++r) s[r] = 0.f;                                 \
        _Pragma("unroll") for (int kk = 0; kk < 4; ++kk) s = __builtin_amdgcn_mfma_f32_32x32x16_bf16(KF[kk], qf[kk], s, 0, 0, 0); \
        float mx = -1e30f;                                                                         \
        const bool edge = ((kt_) == kt1) || (WINDOW && (kt_) == kt0);     \
        float rs = 0.f;                                                                            \
        float pr[16];                                                                              \
        float mn;                                                                                  \
        if (edge) {                                                                                \
            _Pragma("unroll") for (int r = 0; r < 16; ++r) {                                       \
                const int key = (kt_) * 32 + (r & 3) + 8 * (r >> 2) + 4 * hh;                      \
                const bool ok = (key <= qi) && (!WINDOW || (qi - key) < 128);                      \
                s[r] = ok ? s[r] : -1e30f;                                                         \
                mx = fmaxf(mx, s[r]);                                                              \
            }                                                                                      \
            mx = fmaxf(mx, xchg32(mx));                                                    \
            mn = fmaxf(m, mx);                                                                     \
            _Pragma("unroll") for (int r = 0; r < 16; ++r) { pr[r] = (s[r] > -1e29f) ? __builtin_amdgcn_exp2f(s[r] - mn) : 0.f; rs += pr[r]; } \
        } else {                                                                                   \
            _Pragma("unroll") for (int r = 0; r < 16; ++r) mx = fmaxf(mx, s[r]);                   \
            mx = fmaxf(mx, xchg32(mx));                                                    \
            mn = fmaxf(m, mx);                                                                     \
            _Pragma("unroll") for (int r = 0; r < 16; ++r) { pr[r] = __builtin_amdgcn_exp2f(s[r] - mn); rs += pr[r]; } \
        }                                                                                          \
        rs += xchg32(rs);                                                                  \
        if (__any(mn > m)) {         \
            const float alpha = __builtin_amdgcn_exp2f(m - mn);                                    \
            l *= alpha;                                                                            \
            _Pragma("unroll") for (int dt = 0; dt < DVT; ++dt)                                     \
                _Pragma("unroll") for (int r = 0; r < 16; ++r) oT[dt][r] *= alpha;                 \
        }                                                                                          \
        l += rs; m = mn;                                                                           \
        u32x4 pa = {pk2(pr[0], pr[1]), pk2(pr[2], pr[3]), pk2(pr[4], pr[5]), pk2(pr[6], pr[7])};   \
        u32x4 pb = {pk2(pr[8], pr[9]), pk2(pr[10], pr[11]), pk2(pr[12], pr[13]), pk2(pr[14], pr[15])}; \
        const bf16x8 p0 = *(bf16x8*)&pa, p1 = *(bf16x8*)&pb;                                       \
        _Pragma("unroll") for (int dt = 0; dt < DVT; ++dt) {                                       \
            oT[dt] = __builtin_amdgcn_mfma_f32_32x32x16_bf16(VF[dt][0], p0, oT[dt], 0, 0, 0);      \
            oT[dt] = __builtin_amdgcn_mfma_f32_32x32x16_bf16(VF[dt][1], p1, oT[dt], 0, 0, 0);      \
        }                                                                                          \
    }
    ATT_LOAD(kfA, vfA, kt0);
    for (int kt = kt0; kt <= kt1; kt += 2) {
        { const int kn = kt + 1 <= kt1 ? kt + 1 : kt1; ATT_LOAD(kfB, vfB, kn); }
        __builtin_amdgcn_sched_barrier(0);
        ATT_TILE(kfA, vfA, kt);
        if (kt + 1 > kt1) break;
        { const int kn = kt + 2 <= kt1 ? kt + 2 : kt1; ATT_LOAD(kfA, vfA, kn); }
        __builtin_amdgcn_sched_barrier(0);
        ATT_TILE(kfB, vfB, kt + 1);
    }
#undef ATT_LOAD
#undef ATT_TILE
}

__device__ __forceinline__ void phase_swa(KP& p, int layer, const bf16_t* qkv, const bf16_t* kfa, const bf16_t* vta, bf16_t* mix) {
    const int tidq = tid_opaque(), lane = tidq & 63, wv = tidq >> 6;
    int it0, itn;
    if ((int)blockIdx.x >= NBATCH * SSM_G) { it0 = 0; itn = 0; }
    else { const int q = wv * (NBATCH * SSM_G) + (int)blockIdx.x;
           if (q >= 1056) { it0 = 5 * (q - 1056); itn = 5; } else if (q >= 336) { it0 = 2400 + (q - 336); itn = 1; } else { it0 = 0; itn = 0; } }
    const int itend = it0 + itn < NBATCH * 12 * 65 ? it0 + itn : NBATCH * 12 * 65;
    const int r31 = lane & 31, hh = lane >> 5;
    for (int it = it0; it < itend; ++it) {
        const int qb = it % 65, hq = (it / 65) % 12, b = it / (65 * 12), kvh = hq / 3;
        const int qi = qb * 32 + r31, qr = qi < LT ? qi : LT - 1;
        const bf16_t* qrow = qkv + (size_t)(b * LT + qr) * INW + OFF_QA + hq * 64;
        const bf16_t* kbase = kfa + (size_t)(b * 4 + kvh) * NKT * 2048;
        const bf16_t* vT = vta + (size_t)(b * 4 + kvh) * NKT * 2048;
        float m, l; f32x16 oT[2];
        attn_core<2, true>(qrow, kbase, vT, qi, qb >= 4 ? qb - 4 : 0, qb, lane, m, l, oT);
        const float sink = p.sinks[layer * 12 + hq] * 1.4426950408889634f;
        const float M = fmaxf(m, sink), alpha = __builtin_amdgcn_exp2f(m - M);
        const float inv = alpha / (l * alpha + __builtin_amdgcn_exp2f(sink - M));
        if (qi < LT) {
            bf16_t* op = mix + (size_t)(b * LT + qi) * D + hq * 64 + 4 * hh;
#pragma unroll
            for (int dt = 0; dt < 2; ++dt)
#pragma unroll
                for (int a = 0; a < 4; ++a)
                    *(u32x2*)(op + dt * 32 + 8 * a) = (u32x2){pk2(oT[dt][4 * a] * inv, oT[dt][4 * a + 1] * inv), pk2(oT[dt][4 * a + 2] * inv, oT[dt][4 * a + 3] * inv)};
        }
    }
}

__device__ __forceinline__ void phase_diff(const bf16_t* qkv, const bf16_t* kfd, const bf16_t* vtd, bf16_t* dtmp) {
    const int tidq = tid_opaque(), lane = tidq & 63, nw = (gridDim.x * NT) >> 6;
    const int wv = tidq >> 6;
    const bool freeb = (int)blockIdx.x >= NBATCH * SSM_G;
    const int gw = freeb ? ((int)blockIdx.x - NBATCH * SSM_G) * NWV + wv : 1024 + wv * (NBATCH * SSM_G) + (int)blockIdx.x;
    const int ilim = freeb ? 1024 : NBATCH * 4 * 2 * 65, istep = freeb ? 512 : 4096;
    (void)nw;
    const int r31 = lane & 31, hh = lane >> 5;
    for (int ii = gw; ii < ilim; ii += istep) {
        const int it = ii < 512 ? ii : (ii < 1024 ? 2591 - ii : ii - 512);
        const int qb = 64 - it / 32, sub = it & 1, H = (it >> 1) & 3, b = (it >> 3) & 3;
        const int qi = qb * 32 + r31, qr = qi < LT ? qi : LT - 1;
        const bf16_t* qrow = qkv + (size_t)(b * LT + qr) * INW + OFF_QD + H * 128 + sub * 64;
        const bf16_t* kbase = kfd + (size_t)(b * 8 + H * 2 + sub) * NKT * 2048;
        const bf16_t* vT = vtd + (size_t)(b * 4 + H) * NKT * 4096;
        float m, l; f32x16 oT[4];
        attn_core<4, false>(qrow, kbase, vT, qi, 0, qb, lane, m, l, oT);
        const float inv = 1.0f / l;
        if (qi < LT) {
            bf16_t* op = dtmp + (size_t)(b * LT + qi) * 1024 + H * 256 + sub * 128 + 4 * hh;
#pragma unroll
            for (int dt = 0; dt < 4; ++dt)
#pragma unroll
                for (int a = 0; a < 4; ++a)
                    *(u32x2*)(op + dt * 32 + 8 * a) = (u32x2){pk2(oT[dt][4 * a] * inv, oT[dt][4 * a + 1] * inv), pk2(oT[dt][4 * a + 2] * inv, oT[dt][4 * a + 3] * inv)};
        }
    }
}

__device__ __forceinline__ void phase_diff_combine(KP& p, int layer, const bf16_t* dtmp, bf16_t* mix, unsigned* pubc) {
    const int tidq = tid_opaque(), lane = tidq & 63, w = tidq >> 6, q = lane >> 4, l16 = lane & 15;
    const float lam_init = 0.8f - 0.6f * expf(-0.3f * (float)layer);
    const float d1 = wave_sum(p.lq1[layer * 64 + lane] * p.lk1[layer * 64 + lane]);
    const float d2 = wave_sum(p.lq2[layer * 64 + lane] * p.lk2[layer * 64 + lane]);
    const float lam = expf(d1) - expf(d2) + lam_init;
    const f32x4 ga = *(const f32x4*)(p.subln_g + layer * 128 + 8 * l16), gb = *(const f32x4*)(p.subln_g + layer * 128 + 8 * l16 + 4);
    const __amdgpu_buffer_rsrc_t mrs = __builtin_amdgcn_make_buffer_rsrc((void*)mix, 0, NTOK * D * 2, 0x00020000);
    const int nextra = NTOK - MPG8, xb0 = (int)gridDim.x - nextra;
    for (int blk = blockIdx.x; blk < MPG8 / 32; blk += gridDim.x) {
        const bool extra = (int)blockIdx.x >= xb0 && blk == (int)blockIdx.x;
        u32x4 a0[5], a1[5];
        int tk[5];
#pragma unroll
        for (int u = 0; u < 5; ++u) {
            const int i = w * 16 + u * 4 + q;
            const int t = u < 4 ? blk * 32 + (i >> 2) : MPG8 + ((int)blockIdx.x - xb0), H = u < 4 ? (i & 3) : q;
            tk[u] = t * 4 + H;
            const bool on = u < 4 || (extra && w == 0);
            const bf16_t* src = dtmp + (size_t)(on ? t : blk * 32) * 1024 + H * 256 + 8 * l16;
            a0[u] = *(const u32x4*)src; a1[u] = *(const u32x4*)(src + 128);
        }
#pragma unroll
        for (int u = 0; u < 5; ++u) {
            float o[8];
#pragma unroll
            for (int j = 0; j < 4; ++j) { o[2 * j] = __uint_as_float(a0[u][j] << 16) - lam * __uint_as_float(a1[u][j] << 16); o[2 * j + 1] = __uint_as_float(a0[u][j] & 0xffff0000u) - lam * __uint_as_float(a1[u][j] & 0xffff0000u); }
            float ss = 0.f;
#pragma unroll
            for (int j = 0; j < 8; ++j) ss += o[j] * o[j];
            ss += dppx<0xB1>(ss); ss += dppx<0x4E>(ss); ss += dppx<0x141>(ss); ss += dppx<0x140>(ss);
            const float rs = rsqrtf(ss * (1.0f / 128.0f) + EPS) * (1.0f - lam_init);
            const u32x4 ov = {pk2(o[0] * rs * ga[0], o[1] * rs * ga[1]), pk2(o[2] * rs * ga[2], o[3] * rs * ga[3]), pk2(o[4] * rs * gb[0], o[5] * rs * gb[1]), pk2(o[6] * rs * gb[2], o[7] * rs * gb[3])};
            const int t = tk[u] >> 2, H = tk[u] & 3;
            if (u < 4 || (extra && w == 0)) __builtin_amdgcn_raw_buffer_store_b128(ov, mrs, (unsigned)((t * D + 1536 + H * 128 + 8 * l16) * 2), 0, 16);
        }
        asm volatile("s_waitcnt vmcnt(0)" ::: "memory");
        __syncthreads();
        if (tidq == 0) { (void)xb_add(pubc + (blk >> 3), 1u); if (extra) (void)xb_add(pubc + MPG8 / 256, 1u); }
    }
}

typedef short s16x4 __attribute__((ext_vector_type(4)));
constexpr int SSM_NSEG = 8, SSM_PITCH = 72;
__device__ __forceinline__ int ssm_tile0(int k) { return (k * 65) >> 3; }
template <bool FULL>
__device__ __forceinline__ void ssm_pass(KP& p, int layer, const bf16_t* qkv, bf16_t* yb, float* S, unsigned char* lds, const f32x4* ssmt) {
    const int tidq = tid_opaque(), lane = tidq & 63, w = tidq >> 6, c31 = lane & 31, hh = lane >> 5;
    if (blockIdx.x >= NBATCH * SSM_G) return;
    const int item = blockIdx.x * NWV + w;
    const int pair = item >> 3, seg = item & 7, b = pair / SSM_G, g = pair % SSM_G, lg = layer * SSM_G + g;
    float a1r[2], a1i[2], a2r[2], a2i[2], a3r[2], a3i[2], a4r[2], a4i[2], a256r[2], a256i[2];
    bf16x8 bfr[4];
#pragma unroll
    for (int pp = 0; pp < 2; ++pp) {
        const int gp = lg * SSM_P + pp * 32 + c31;
        const f32x4 tv = ssmt[gp], tv2 = ssmt[2 * SSM_G * SSM_P + gp], tv4 = ssmt[4 * SSM_G * SSM_P + gp];
        const float fr = tv[2], fi = tv[3];
        a1r[pp] = tv[0]; a1i[pp] = tv[1]; a2r[pp] = tv2[0]; a2i[pp] = tv2[1]; a3r[pp] = tv2[2]; a3i[pp] = tv2[3]; a4r[pp] = tv4[0]; a4i[pp] = tv4[1];
        a256r[pp] = tv4[2]; a256i[pp] = tv4[3];
        const f32x4 br0 = *(const f32x4*)(p.b_re + (size_t)gp * 16 + 8 * hh), br1 = *(const f32x4*)(p.b_re + (size_t)gp * 16 + 8 * hh + 4);
        const f32x4 bi0 = *(const f32x4*)(p.b_im + (size_t)gp * 16 + 8 * hh), bi1 = *(const f32x4*)(p.b_im + (size_t)gp * 16 + 8 * hh + 4);
        u32x4 wr = {pk2(fr * br0[0] - fi * bi0[0], fr * br0[1] - fi * bi0[1]), pk2(fr * br0[2] - fi * bi0[2], fr * br0[3] - fi * bi0[3]),
                    pk2(fr * br1[0] - fi * bi1[0], fr * br1[1] - fi * bi1[1]), pk2(fr * br1[2] - fi * bi1[2], fr * br1[3] - fi * bi1[3])};
        u32x4 wi = {pk2(fr * bi0[0] + fi * br0[0], fr * bi0[1] + fi * br0[1]), pk2(fr * bi0[2] + fi * br0[2], fr * bi0[3] + fi * br0[3]),
                    pk2(fr * bi1[0] + fi * br1[0], fr * bi1[1] + fi * br1[1]), pk2(fr * bi1[2] + fi * br1[2], fr * bi1[3] + fi * br1[3])};
        bfr[pp] = *(bf16x8*)&wr; bfr[2 + pp] = *(bf16x8*)&wi;
    }
    float a16r[2], a16i[2];
#pragma unroll
    for (int pp = 0; pp < 2; ++pp) {
        const float a8r = a4r[pp] * a4r[pp] - a4i[pp] * a4i[pp], a8i = a4r[pp] * a4i[pp] + a4i[pp] * a4r[pp];
        a16r[pp] = a8r * a8r - a8i * a8i; a16i[pp] = a8r * a8i + a8i * a8r;
    }
    unsigned char* ctab = lds + NWV * (128 * SSM_PITCH);
    if (FULL) {
        {
            const int kk = w;
            u32x4 wv = {0u, 0u, 0u, 0u};
            if (c31 < 16) {
                const int pbase = (16 * kk + 8 * hh) & 63;
                const float* cp = ((kk >> 2) ? p.c_im : p.c_re) + ((size_t)lg * 16 + c31) * SSM_P + pbase;
                const float sg = (kk >> 2) ? -1.0f : 1.0f;
                const f32x4 c0 = *(const f32x4*)cp, c1 = *(const f32x4*)(cp + 4);
                wv = (u32x4){pk2(sg * c0[0], sg * c0[1]), pk2(sg * c0[2], sg * c0[3]), pk2(sg * c1[0], sg * c1[1]), pk2(sg * c1[2], sg * c1[3])};
            }
            *(u32x4*)(ctab + (kk * 64 + lane) * 16) = wv;
        }
        if (w == 0) {
            const float dsk = (c31 < 16) ? p.dskip[layer * SSM_W + g * 16 + c31] : 0.f;
            float dv[8];
#pragma unroll
            for (int j = 0; j < 8; ++j) dv[j] = (8 * hh + j == c31) ? dsk : 0.f;
            u32x4 wd = {pk2(dv[0], dv[1]), pk2(dv[2], dv[3]), pk2(dv[4], dv[5]), pk2(dv[6], dv[7])};
            *(u32x4*)(ctab + (8 * 64 + lane) * 16) = wd;
        }
        __syncthreads();
    }
    float cr[2] = {0.f, 0.f}, ci[2] = {0.f, 0.f};
    if (FULL && seg > 0) {
        float pr[2] = {a256r[0], a256r[1]}, pi[2] = {a256i[0], a256i[1]};
        for (int k2 = 0; k2 < seg; ++k2) {
            const float* sp = S + k2 * 128 + c31;
#pragma unroll
            for (int pp = 0; pp < 2; ++pp) {
                const float sr = sp[pp * 32], si = sp[64 + pp * 32];
                const float nr2 = pr[pp] * cr[pp] - pi[pp] * ci[pp] + sr, ni2 = pr[pp] * ci[pp] + pi[pp] * cr[pp] + si;
                cr[pp] = nr2; ci[pp] = ni2;
            }
        }
    }
    unsigned char* img = lds + w * (128 * SSM_PITCH);
    const int t1 = ssm_tile0(seg + 1);
    const int tperm = (c31 & 3) | ((c31 >> 3) << 2) | (((c31 >> 2) & 1) << 4);
    bf16x8 uf_nx, ufn_nx = {0, 0, 0, 0, 0, 0, 0, 0};
    {
        const int t0_ = ssm_tile0(seg), tp = t0_ * 32 + tperm, tq = t0_ * 32 + c31;
        uf_nx = *(const bf16x8*)(qkv + (size_t)(b * LT + (tp < LT ? tp : LT - 1)) * INW + OFF_US + g * 16 + 8 * hh);
        if (FULL) ufn_nx = *(const bf16x8*)(qkv + (size_t)(b * LT + (tq < LT ? tq : LT - 1)) * INW + OFF_US + g * 16 + 8 * hh);
    }
    for (int tile = ssm_tile0(seg); tile < t1; ++tile) {
        const bf16x8 z8 = {0, 0, 0, 0, 0, 0, 0, 0};
        const bf16x8 uf = (tile * 32 + tperm < LT) ? uf_nx : z8;
        const bf16x8 ufn = (FULL && tile * 32 + c31 < LT) ? ufn_nx : z8;
        {
            const int tn = tile + 1 < t1 ? tile + 1 : tile;
            const int tp = tn * 32 + tperm, tq = tn * 32 + c31;
            uf_nx = *(const bf16x8*)(qkv + (size_t)(b * LT + (tp < LT ? tp : LT - 1)) * INW + OFF_US + g * 16 + 8 * hh);
            if (FULL) ufn_nx = *(const bf16x8*)(qkv + (size_t)(b * LT + (tq < LT ? tq : LT - 1)) * INW + OFF_US + g * 16 + 8 * hh);
        }
        f32x16 V[4];
#pragma unroll
        for (int i = 0; i < 4; ++i) {
            f32x16 z;
#pragma unroll
            for (int r = 0; r < 16; ++r) z[r] = 0.f;
            V[i] = __builtin_amdgcn_mfma_f32_32x32x16_bf16(uf, bfr[i], z, 0, 0, 0);
        }
#pragma unroll
        for (int pp = 0; pp < 2; ++pp)
#pragma unroll
            for (int a = 0; a < 4; ++a)
#pragma unroll
                for (int i = 1; i < 4; ++i) {
                    const float xr = V[pp][4 * a + i - 1], xi = V[2 + pp][4 * a + i - 1];
                    V[pp][4 * a + i] += a1r[pp] * xr - a1i[pp] * xi;
                    V[2 + pp][4 * a + i] += a1r[pp] * xi + a1i[pp] * xr;
                }
        float cinr[2][4], cini[2][4];
#pragma unroll
        for (int pp = 0; pp < 2; ++pp) {
            float zr = 0.f, zi = 0.f;
#pragma unroll
            for (int a = 0; a < 4; ++a) {
                cinr[pp][a] = zr; cini[pp][a] = zi;
                const float nr2 = V[pp][4 * a + 3] + a4r[pp] * zr - a4i[pp] * zi, ni2 = V[2 + pp][4 * a + 3] + a4r[pp] * zi + a4i[pp] * zr;
                zr = nr2; zi = ni2;
            }
            const float lor = xchg32(zr), loi = xchg32(zi);
            const float tr = a16r[pp] * cr[pp] - a16i[pp] * ci[pp] + lor, ti = a16r[pp] * ci[pp] + a16i[pp] * cr[pp] + loi;
            const float kr = hh ? tr : cr[pp], ki = hh ? ti : ci[pp];
            if (FULL) {
                const float w1r = a4r[pp] * kr - a4i[pp] * ki, w1i = a4r[pp] * ki + a4i[pp] * kr;
                const float w2r = a4r[pp] * w1r - a4i[pp] * w1i, w2i = a4r[pp] * w1i + a4i[pp] * w1r;
                const float w3r = a4r[pp] * w2r - a4i[pp] * w2i, w3i = a4r[pp] * w2i + a4i[pp] * w2r;
                cinr[pp][1] += w1r; cini[pp][1] += w1i; cinr[pp][2] += w2r; cini[pp][2] += w2i; cinr[pp][3] += w3r; cini[pp][3] += w3i;
                cinr[pp][0] = kr; cini[pp][0] = ki;
            }
            const float er = a16r[pp] * kr - a16i[pp] * ki + zr, ei = a16r[pp] * ki + a16i[pp] * kr + zi;
            const float our = xchg32(er), oui = xchg32(ei);
            cr[pp] = hh ? er : our; ci[pp] = hh ? ei : oui;
        }
        if (FULL) {
#pragma unroll
            for (int pp = 0; pp < 2; ++pp)
#pragma unroll
                for (int a = 0; a < 4; ++a) {
                    const float kr = cinr[pp][a], ki = cini[pp][a];
                    V[pp][4 * a + 0] += a1r[pp] * kr - a1i[pp] * ki; V[2 + pp][4 * a + 0] += a1r[pp] * ki + a1i[pp] * kr;
                    V[pp][4 * a + 1] += a2r[pp] * kr - a2i[pp] * ki; V[2 + pp][4 * a + 1] += a2r[pp] * ki + a2i[pp] * kr;
                    V[pp][4 * a + 2] += a3r[pp] * kr - a3i[pp] * ki; V[2 + pp][4 * a + 2] += a3r[pp] * ki + a3i[pp] * kr;
                    V[pp][4 * a + 3] += a4r[pp] * kr - a4i[pp] * ki; V[2 + pp][4 * a + 3] += a4r[pp] * ki + a4i[pp] * kr;
                }
#pragma unroll
            for (int i = 0; i < 4; ++i)
#pragma unroll
                for (int a = 0; a < 4; ++a)
                    *(u32x2*)(img + (i * 32 + c31) * SSM_PITCH + (16 * hh + 4 * a) * 2) = (u32x2){pk2(V[i][4 * a], V[i][4 * a + 1]), pk2(V[i][4 * a + 2], V[i][4 * a + 3])};
            f32x16 y;
#pragma unroll
            for (int r = 0; r < 16; ++r) y[r] = 0.f;
            const int li15 = lane & 15, gsel = (lane >> 4) & 1;
#pragma unroll
            for (int kk = 0; kk < 8; ++kk) {
                const unsigned char* rp = img + (16 * kk + 8 * hh + (li15 >> 2)) * SSM_PITCH + (16 * gsel + 4 * (li15 & 3)) * 2;
                const s16x4 lo = __builtin_amdgcn_ds_read_tr16_b64_v4i16((__attribute__((address_space(3))) s16x4*)(rp));
                const s16x4 hi = __builtin_amdgcn_ds_read_tr16_b64_v4i16((__attribute__((address_space(3))) s16x4*)(rp + 4 * SSM_PITCH));
                const bf16x8 af = {lo[0], lo[1], lo[2], lo[3], hi[0], hi[1], hi[2], hi[3]};
                y = __builtin_amdgcn_mfma_f32_32x32x16_bf16(af, *(const bf16x8*)(ctab + (kk * 64 + lane) * 16), y, 0, 0, 0);
            }
            y = __builtin_amdgcn_mfma_f32_32x32x16_bf16(ufn, *(const bf16x8*)(ctab + (8 * 64 + lane) * 16), y, 0, 0, 0);
            {
                const int cc = c31 & 15, rsel = c31 >> 4;
#pragma unroll
                for (int r = 0; r < 8; ++r) {
                    const auto sw = __builtin_amdgcn_permlane16_swap(__float_as_uint(y[r]), __float_as_uint(y[r + 8]), false, false);
                    const float v = __uint_as_float(sw[0]);
                    const int rr = r + 8 * rsel;
                    const int tk = tile * 32 + (rr & 3) + 8 * (rr >> 2) + 4 * hh;
                    if (tk < LT) {
                        const float z2 = 1.5957691216057308f * (v + 0.044715f * v * v * v);
                        yb[(size_t)(b * LT + tk) * SSM_W + g * 16 + cc] = f2bf(v * __builtin_amdgcn_rcpf(1.0f + __expf(-z2)));
                    }
                }
            }
        }
    }
    if (!FULL && hh == 0) {
        float* sp = S + seg * 128 + c31;
        sp[0] = cr[0]; sp[32] = cr[1]; sp[64] = ci[0]; sp[96] = ci[1];
    }
}

template <int MODE>
__device__ __forceinline__ void phase_gemm_dense(unsigned char* lds, const bf16_t* A, int K, const float* B, int N, float* h, bf16_t* outb, const bf16_t* yb, int tm_lo, int ksplit, const bf16_t* zrow, unsigned* pubc = nullptr, unsigned* waitc = nullptr, unsigned* bar = nullptr) {
    const int npair = N / 256, ntm = (NTOK + BM - 1) / BM - tm_lo, Ksub = K / ksplit;
    const int tid = tid_opaque(), lane = tid & 63, th = tid & 255, wave = (tid >> 6) & 3, wm = wave >> 1, wn = wave & 1, c31 = lane & 31, hh = lane >> 5;
    const int hsel = __builtin_amdgcn_readfirstlane(tid >> 8);
    f32x4 rbs[2][8];
    bool bpre = false;
    const __amdgpu_buffer_rsrc_t prs = __builtin_amdgcn_make_buffer_rsrc((void*)h, 0, 16 * (NTOK - MPG8) * D * 4, 0x00020000);
    int task0 = (int)blockIdx.x;
    if (MODE == 3) { task0 -= (int)gridDim.x - npair * ntm * ksplit; if (task0 < 0) task0 += (int)gridDim.x; }
    if (MODE == 3 && task0 < npair * ntm * ksplit) {
        if (tid == 0) { XB_SPIN(xb_ld(waitc) < 67u, bar); __builtin_amdgcn_fence(__ATOMIC_ACQUIRE, "agent"); asm volatile("s_waitcnt vmcnt(0)" ::: "memory"); }
        __syncthreads();
    }
    for (int task = task0; task < npair * ntm * ksplit; task += gridDim.x) {
        const int ks = task % ksplit, tile = task / ksplit;
        int tm = tm_lo + tile % ntm; const int tn = 2 * (tile / ntm) + hsel;
        asm volatile("" : "+s"(tm));
        const int rb_ = tm * BM + 64 * hsel + (th >> 3);
        const bf16_t* ap0 = rb_ < NTOK ? A + (size_t)rb_ * K + ks * Ksub : zrow;
        const bf16_t* ap1 = rb_ + 32 < NTOK ? A + (size_t)(rb_ + 32) * K + ks * Ksub : zrow;
        const float* bp = B + (size_t)ks * Ksub * N + tn * 128 + 4 * (th & 31);
        const int task2 = task + gridDim.x; const bool has_next = task2 < npair * ntm * ksplit;
        const float* bnext = has_next ? B + (size_t)(task2 % ksplit) * Ksub * N + (2 * ((task2 / ksplit) / ntm) + hsel) * 128 + 4 * (th & 31) : bp;
        f32x16 acc[2][2];
        gemm_dual(lds, ap0, ap1, bp, N, Ksub, acc, rbs, bpre, bnext);
        bpre = has_next;
        const int cb = tn * 128 + wn * 64;
        if (MODE == 3) {
#pragma unroll
            for (int mi = 0; mi < 2; ++mi)
#pragma unroll
                for (int a4 = 0; a4 < 4; ++a4) {
                    const int t = tm * BM + wm * 64 + mi * 32 + 8 * a4 + 4 * hh + (lane & 3);
#pragma unroll
                    for (int ni = 0; ni < 2; ++ni) {
                        float v0 = acc[mi][ni][4 * a4], v1 = acc[mi][ni][4 * a4 + 1], v2 = acc[mi][ni][4 * a4 + 2], v3 = acc[mi][ni][4 * a4 + 3];
                        quad_transpose(v0, v1, v2, v3, lane);
                        if (t < NTOK) { const f32x4 o = {v0, v1, v2, v3}; __builtin_amdgcn_raw_buffer_store_b128(*(const u32x4*)&o, prs, (unsigned)((((ks * (NTOK - MPG8) + (t - MPG8)) * D) + cb + ni * 32 + (c31 & ~3)) * 4), 0, 16); }
                    }
                }
            asm volatile("s_waitcnt vmcnt(0)" ::: "memory");
            __syncthreads();
            if (tid == 0) (void)xb_add(pubc, 1u);
        } else {
            u32x2 y8[2][4][2];
#pragma unroll
            for (int mi = 0; mi < 2; ++mi)
#pragma unroll
                for (int a4 = 0; a4 < 4; ++a4) {
                    const int t = tm * BM + wm * 64 + mi * 32 + 8 * a4 + 4 * hh + (lane & 3);
#pragma unroll
                    for (int ni = 0; ni < 2; ++ni) y8[mi][a4][ni] = t < NTOK ? *(const u32x2*)(yb + (size_t)t * SSM_W + cb + ni * 32 + (c31 & ~3)) : (u32x2){0u, 0u};
                }
            const __amdgpu_buffer_rsrc_t mrs = __builtin_amdgcn_make_buffer_rsrc((void*)outb, 0, NTOK * D * 2, 0x00020000);
            const bool odd = (lane & 4) != 0;
#pragma unroll
            for (int mi = 0; mi < 2; ++mi)
#pragma unroll
                for (int ni = 0; ni < 2; ++ni)
#pragma unroll
                    for (int k2 = 0; k2 < 2; ++k2) {
                        u32x2 d[2];
#pragma unroll
                        for (int s = 0; s < 2; ++s) {
                            const int a4 = 2 * k2 + s;
                            float v0 = acc[mi][ni][4 * a4], v1 = acc[mi][ni][4 * a4 + 1], v2 = acc[mi][ni][4 * a4 + 2], v3 = acc[mi][ni][4 * a4 + 3];
                            quad_transpose(v0, v1, v2, v3, lane);
                            const u32x2 yv = y8[mi][a4][ni];
                            const float y0 = __uint_as_float(yv[0] << 16), y1 = __uint_as_float(yv[0] & 0xffff0000u), y2 = __uint_as_float(yv[1] << 16), y3 = __uint_as_float(yv[1] & 0xffff0000u);
                            d[s] = (u32x2){pk2(y0 * __builtin_amdgcn_rcpf(1.0f + __expf(-v0)), y1 * __builtin_amdgcn_rcpf(1.0f + __expf(-v1))),
                                           pk2(y2 * __builtin_amdgcn_rcpf(1.0f + __expf(-v2)), y3 * __builtin_amdgcn_rcpf(1.0f + __expf(-v3)))};
                        }
                        const unsigned s0 = odd ? d[0][0] : d[1][0], s1 = odd ? d[0][1] : d[1][1];
                        const unsigned r0 = (unsigned)__builtin_amdgcn_ds_swizzle((int)s0, 0x101F), r1 = (unsigned)__builtin_amdgcn_ds_swizzle((int)s1, 0x101F);
                        const unsigned k0 = odd ? d[1][0] : d[0][0], k1 = odd ? d[1][1] : d[0][1];
                        const u32x4 o = odd ? (u32x4){r0, r1, k0, k1} : (u32x4){k0, k1, r0, r1};
                        const int t = tm * BM + wm * 64 + mi * 32 + 8 * (2 * k2 + (odd ? 1 : 0)) + 4 * hh + (lane & 3);
                        if (t < NTOK) __builtin_amdgcn_raw_buffer_store_b128(o, mrs, (unsigned)((t * D + 768 + cb + ni * 32 + (c31 & ~7)) * 2), 0, 16);
                    }
            asm volatile("s_waitcnt vmcnt(0)" ::: "memory");
            __syncthreads();
            if (tid == 0) (void)xb_add(pubc + (tm < MPG8 / BM ? (tm >> 1) : MPG8 / 256), 1u);
        }
    }
}

__device__ __forceinline__ void phase_router(KP& p, int layer, float* h, bf16_t* xn, float* selw, int* lists, int* cnt, const bf16_t* rtab, unsigned char* lds, const float* part_, unsigned* rtc, unsigned* loc, unsigned* bar) {
    const int tid = tid_opaque(), lane = tid & 63, w = tid >> 6, r31 = lane & 31, hh = lane >> 5;
    const bf16_t* thi = rtab + (size_t)(layer * 2 + 0) * 36 * D; const bf16_t* tlo = rtab + (size_t)(layer * 2 + 1) * 36 * D;
    const float* g = p.ffn_g + (size_t)layer * D;
    float* part = (float*)lds;
    float* rsb = (float*)(lds + 8 * 21 * 64 * 4);
    for (int item = blockIdx.x; item < MPG8 / 32; item += gridDim.x) {
        if (tid == 0) { XB_SPIN(xb_ld(&rtc[item >> 3]) < (unsigned)(D / 256), bar); __builtin_amdgcn_fence(__ATOMIC_ACQUIRE, "agent"); asm volatile("s_waitcnt vmcnt(0)" ::: "memory"); }
        __syncthreads();
        const int t = item * 32 + r31;
        const float* hrow = h + (size_t)t * D + w * 256 + 8 * hh;
        f32x16 a0, a1;
#pragma unroll
        for (int r = 0; r < 16; ++r) { a0[r] = 0.f; a1[r] = 0.f; }
        float ss = 0.f;
#pragma unroll 4
        for (int ks = 0; ks < 16; ++ks) {
            const f32x4 x0 = *(const f32x4*)(hrow + ks * 16), x1 = *(const f32x4*)(hrow + ks * 16 + 4);
            ss += x0[0] * x0[0] + x0[1] * x0[1] + x0[2] * x0[2] + x0[3] * x0[3] + x1[0] * x1[0] + x1[1] * x1[1] + x1[2] * x1[2] + x1[3] * x1[3];
            u32x4 bh = {pk2(x0[0], x0[1]), pk2(x0[2], x0[3]), pk2(x1[0], x1[1]), pk2(x1[2], x1[3])};
            u32x4 bl = {pk2(x0[0] - __uint_as_float(bh[0] << 16), x0[1] - __uint_as_float(bh[0] & 0xffff0000u)), pk2(x0[2] - __uint_as_float(bh[1] << 16), x0[3] - __uint_as_float(bh[1] & 0xffff0000u)),
                        pk2(x1[0] - __uint_as_float(bh[2] << 16), x1[1] - __uint_as_float(bh[2] & 0xffff0000u)), pk2(x1[2] - __uint_as_float(bh[3] << 16), x1[3] - __uint_as_float(bh[3] & 0xffff0000u))};
            const bf16x8 hhi = *(bf16x8*)&bh, hlo = *(bf16x8*)&bl;
            const size_t ko = (size_t)w * 256 + ks * 16 + 8 * hh;
            const size_t kf = ((size_t)(w * 16 + ks) * 64 + lane) * 8;
            const bf16x8 w0h = *(const bf16x8*)(thi + kf), w0l = *(const bf16x8*)(tlo + kf);
            bf16x8 w1h = {0, 0, 0, 0, 0, 0, 0, 0}, w1l = {0, 0, 0, 0, 0, 0, 0, 0};
            if (r31 < 4) { w1h = *(const bf16x8*)(thi + (size_t)(32 + r31) * D + ko); w1l = *(const bf16x8*)(tlo + (size_t)(32 + r31) * D + ko); }
            a0 = __builtin_amdgcn_mfma_f32_32x32x16_bf16(w0h, hhi, a0, 0, 0, 0);
            a0 = __builtin_amdgcn_mfma_f32_32x32x16_bf16(w0h, hlo, a0, 0, 0, 0);
            a0 = __builtin_amdgcn_mfma_f32_32x32x16_bf16(w0l, hhi, a0, 0, 0, 0);
            a1 = __builtin_amdgcn_mfma_f32_32x32x16_bf16(w1h, hhi, a1, 0, 0, 0);
            a1 = __builtin_amdgcn_mfma_f32_32x32x16_bf16(w1h, hlo, a1, 0, 0, 0);
            a1 = __builtin_amdgcn_mfma_f32_32x32x16_bf16(w1l, hhi, a1, 0, 0, 0);
        }
#pragma unroll
        for (int r = 0; r < 16; ++r) part[(w * 21 + r) * 64 + lane] = a0[r];
#pragma unroll
        for (int r = 0; r < 4; ++r) part[(w * 21 + 16 + r) * 64 + lane] = a1[r];
        part[(w * 21 + 20) * 64 + lane] = ss;
        __syncthreads();
        if (w == 0) {
            float el[16], gl[4], st = 0.f;
#pragma unroll
            for (int r = 0; r < 16; ++r) { float s = 0.f;
#pragma unroll
                for (int q = 0; q < 8; ++q) s += part[(q * 21 + r) * 64 + lane]; el[r] = s; }
#pragma unroll
            for (int r = 0; r < 4; ++r) { float s = 0.f;
#pragma unroll
                for (int q = 0; q < 8; ++q) s += part[(q * 21 + 16 + r) * 64 + lane]; gl[r] = s; }
#pragma unroll
            for (int q = 0; q < 8; ++q) st += part[(q * 21 + 20) * 64 + lane];
            st += xchg32(st);
            const float rs = rsqrtf(st * (1.0f / D) + EPS);
            if (hh == 0) rsb[r31] = rs;
#pragma unroll
            for (int c = 0; c < 4; ++c) { const float o = xchg32(gl[c]); gl[c] = (hh == 0 ? gl[c] : o) * rs + p.rg_b[layer * 4 + c]; }
            int gs = 0; float gm = gl[0];
#pragma unroll
            for (int c = 1; c < 4; ++c) if (gl[c] > gm) { gm = gl[c]; gs = c; }
            float gsum = 0.f;
#pragma unroll
            for (int c = 0; c < 4; ++c) gsum += expf(gl[c] - gm);
            const float pg = 1.0f / gsum;
            float e4[4];
#pragma unroll
            for (int i = 0; i < 4; ++i) { float v = el[i];
#pragma unroll
                for (int gi = 1; gi < 4; ++gi) v = (gs == gi) ? el[4 * gi + i] : v;
                float bb = p.re_b[layer * 32 + 4 * hh + i];
#pragma unroll
                for (int gi = 1; gi < 4; ++gi) bb = (gs == gi) ? p.re_b[layer * 32 + gi * 8 + 4 * hh + i] : bb;
                e4[i] = v * rs + bb; }
            int i1 = 0; float b1 = e4[0];
#pragma unroll
            for (int i = 1; i < 4; ++i) if (e4[i] > b1) { b1 = e4[i]; i1 = i; }
            int i2 = -1; float b2 = -3.0e38f;
#pragma unroll
            for (int i = 0; i < 4; ++i) if (i != i1 && e4[i] > b2) { b2 = e4[i]; i2 = i; }
            i1 += 4 * hh; i2 += 4 * hh;
            const float ob1 = xchg32(b1), ob2 = xchg32(b2); const int oi1 = xchg32i(i1), oi2 = xchg32i(i2);
            float f1, f2; int j1, j2;
            const bool mine_first = (b1 > ob1) || (b1 == ob1 && i1 < oi1);
            if (mine_first) { f1 = b1; j1 = i1; const bool s = (b2 > ob1) || (b2 == ob1 && i2 < oi1); f2 = s ? b2 : ob1; j2 = s ? i2 : oi1; }
            else { f1 = ob1; j1 = oi1; const bool s = (ob2 > b1) || (ob2 == b1 && oi2 < i1); f2 = s ? ob2 : b1; j2 = s ? oi2 : i1; }
            const float x2 = expf(f2 - f1);
            const float w1 = pg / (1.0f + x2), w2 = pg * x2 / (1.0f + x2);
            if (hh == 0) {
                const int e1 = gs * 8 + j1, e2 = gs * 8 + j2;
                const int p1 = atomicAdd(&cnt[e1], 1); lists[(size_t)e1 * NTOK + p1] = 2 * t; selw[2 * t] = w1;
                const int p2 = atomicAdd(&cnt[e2], 1); lists[(size_t)e2 * NTOK + p2] = 2 * t + 1; selw[2 * t + 1] = w2;
            }
        }
        __syncthreads();
        {
            const float rs = rsb[r31];
            bf16_t* xrow = xn + (size_t)t * D + w * 256 + 8 * hh;
            const float* gk = g + w * 256 + 8 * hh;
            for (int kb = 0; kb < 16; kb += 8) {
                f32x4 x0[8], x1[8], g0[8], g1[8];
#pragma unroll
                for (int u = 0; u < 8; ++u) { const int ks = kb + u; x0[u] = *(const f32x4*)(hrow + ks * 16); x1[u] = *(const f32x4*)(hrow + ks * 16 + 4); g0[u] = *(const f32x4*)(gk + ks * 16); g1[u] = *(const f32x4*)(gk + ks * 16 + 4); }
#pragma unroll
                for (int u = 0; u < 8; ++u) { const int ks = kb + u;
                    *(u32x4*)(xrow + ks * 16) = (u32x4){pk2(x0[u][0] * rs * g0[u][0], x0[u][1] * rs * g0[u][1]), pk2(x0[u][2] * rs * g0[u][2], x0[u][3] * rs * g0[u][3]), pk2(x1[u][0] * rs * g1[u][0], x1[u][1] * rs * g1[u][1]), pk2(x1[u][2] * rs * g1[u][2], x1[u][3] * rs * g1[u][3])}; }
            }
        }
        __syncthreads();
    }
    {
        float* red = (float*)(lds + 49152);
        float* fin = red + 8 * 40;
        for (int te = MPG8 + blockIdx.x; te < NTOK; te += gridDim.x) {
            if (tid == 0) { XB_SPIN(xb_ld(loc) < 128u, bar); __builtin_amdgcn_fence(__ATOMIC_ACQUIRE, "agent"); asm volatile("s_waitcnt vmcnt(0)" ::: "memory"); }
            __syncthreads();
            const int k0 = 4 * tid;
            float* hr = h + (size_t)te * D + k0;
            f32x4 x = *(const f32x4*)hr;
            {
                const float* pp = part_ + (size_t)(te - MPG8) * D + k0;
                f32x4 pv[16];
#pragma unroll
                for (int ks = 0; ks < 16; ++ks) pv[ks] = *(const f32x4*)(pp + (size_t)ks * (NTOK - MPG8) * D);
#pragma unroll
                for (int ks = 0; ks < 16; ++ks) x += pv[ks];
            }
            const f32x4 gv = *(const f32x4*)(g + k0);
            const float bias = tid < 32 ? p.re_b[layer * 32 + tid] : (tid < 36 ? p.rg_b[layer * 4 + tid - 32] : 0.f);
            float al[36];
#pragma unroll
            for (int c = 0; c < 36; ++c) al[c] = 0.f;
#pragma unroll
            for (int kk = 0; kk < 4; ++kk) {
                const float xg = x[kk] * gv[kk];
                const float* wr = p.re_w + ((size_t)layer * D + k0 + kk) * 32;
#pragma unroll
                for (int c4 = 0; c4 < 8; ++c4) { const f32x4 wv = *(const f32x4*)(wr + 4 * c4); al[4 * c4] += xg * wv[0]; al[4 * c4 + 1] += xg * wv[1]; al[4 * c4 + 2] += xg * wv[2]; al[4 * c4 + 3] += xg * wv[3]; }
                const f32x4 wg = *(const f32x4*)(p.rg_w + ((size_t)layer * D + k0 + kk) * 4);
                al[32] += xg * wg[0]; al[33] += xg * wg[1]; al[34] += xg * wg[2]; al[35] += xg * wg[3];
            }
            float ss = wave_sum(x[0] * x[0] + x[1] * x[1] + x[2] * x[2] + x[3] * x[3]);
#pragma unroll
            for (int c = 0; c < 36; ++c) al[c] = wave_sum(al[c]);
            if (lane == 0) {
#pragma unroll
                for (int c = 0; c < 36; ++c) red[w * 40 + c] = al[c];
                red[w * 40 + 36] = ss;
            }
            __syncthreads();
            float rs;
            {
                float s = 0.f, s2 = 0.f;
#pragma unroll
                for (int q = 0; q < 8; ++q) { s += red[q * 40 + (tid < 36 ? tid : 36)]; s2 += red[q * 40 + 36]; }
                rs = rsqrtf(s2 * (1.0f / D) + EPS);
                if (tid < 36) fin[tid] = s * rs + bias;
            }
            __syncthreads();
            if (tid == 0) {
                float gl[4];
#pragma unroll
                for (int c = 0; c < 4; ++c) gl[c] = fin[32 + c];
                int gs = 0; float gm = gl[0];
#pragma unroll
                for (int c = 1; c < 4; ++c) if (gl[c] > gm) { gm = gl[c]; gs = c; }
                float gsum = 0.f;
#pragma unroll
                for (int c = 0; c < 4; ++c) gsum += expf(gl[c] - gm);
                const float pg = 1.0f / gsum;
                float f1 = -3.0e38f, f2 = -3.0e38f; int j1 = 0, j2 = 0;
                for (int i = 0; i < 8; ++i) {
                    const float v = fin[gs * 8 + i];
                    if (v > f1) { f2 = f1; j2 = j1; f1 = v; j1 = i; } else if (v > f2) { f2 = v; j2 = i; }
                }
                const float x2 = expf(f2 - f1);
                const float w1 = pg / (1.0f + x2), w2 = pg * x2 / (1.0f + x2);
                const int e1 = gs * 8 + j1, e2 = gs * 8 + j2;
                const int p1 = atomicAdd(&cnt[e1], 1); lists[(size_t)e1 * NTOK + p1] = 2 * te; selw[2 * te] = w1;
                const int p2 = atomicAdd(&cnt[e2], 1); lists[(size_t)e2 * NTOK + p2] = 2 * te + 1; selw[2 * te + 1] = w2;
            }
            *(f32x4*)hr = x;
            *(u32x2*)(xn + (size_t)te * D + k0) = (u32x2){pk2(x[0] * rs * gv[0], x[1] * rs * gv[1]), pk2(x[2] * rs * gv[2], x[3] * rs * gv[3])};
            __syncthreads();
        }
    }
}

__device__ __forceinline__ void moe_decode(int lt, const int (&ex4)[4], const int (&ntm4)[4], int ntq, int& e, int& j, int& tq) {
    int r = lt, ntm = ntm4[0], q = 0; e = ex4[0];
#pragma unroll
    for (int k = 1; k < 4; ++k) { const int span = ntm4[k - 1] * ntq; if (q == k - 1 && r >= span) { r -= span; q = k; e = ex4[k]; ntm = ntm4[k]; } }
    ntm = ntm > 0 ? ntm : 1;
    j = r % ntm; tq = r / ntm;
}
__device__ __forceinline__ void moe_decode2(int lt, int totU, const int (&ex4)[4], const int (&ntm4)[4], bool& up, int& e, int& j, int& tq) {
    up = lt < totU;
    moe_decode(up ? lt : lt - totU, ex4, ntm4, up ? DEXP / 128 : D / 256, e, j, tq);
}
__device__ __forceinline__ void phase_moe2(KP& p, int layer, unsigned char* lds, const bf16_t* xn, bf16_t* G, bf16_t* Y, const float* selw, const int* lists, const int* cnt, const bf16_t* zrow, unsigned* dep, unsigned* bar) {
    int* rowa = (int*)(lds + LDS_ROWA);
    const int tid = tid_opaque(), lane = tid & 63, wave = (tid >> 6) & 3, wm = wave >> 1, wn = wave & 1, c31 = lane & 31, hh = lane >> 5;
    const int hsel = __builtin_amdgcn_readfirstlane(tid >> 8);
    const int xg = blockIdx.x & 7, jg = blockIdx.x >> 3, nbx = ((int)gridDim.x - xg + 7) >> 3;
    int* order = (int*)(lds + LDS_PRE);
    volatile int* misc = (volatile int*)(lds + LDS_PRE + 192);
    if (tid < NEXP) {
        const int ce = cnt[tid]; int rank = 0;
        for (int e2 = 0; e2 < NEXP; ++e2) { const int c2 = cnt[e2]; rank += (c2 > ce || (c2 == ce && e2 < tid)) ? 1 : 0; }
        order[rank] = tid;
    }
    __syncthreads();
    int ex4[4] = {__builtin_amdgcn_readfirstlane(order[xg]), __builtin_amdgcn_readfirstlane(order[15 - xg]), __builtin_amdgcn_readfirstlane(order[16 + xg]), __builtin_amdgcn_readfirstlane(order[31 - xg])};
    int ntm4[4], sumtm = 0;
#pragma unroll
    for (int q = 0; q < 4; ++q) { ntm4[q] = __builtin_amdgcn_readfirstlane((cnt[ex4[q]] + BM - 1) / BM); sumtm += ntm4[q]; }
    const int totU = sumtm * (DEXP / 128), tot = totU + sumtm * (D / 256);
    unsigned* tkt = dep + 32 * xg;
    unsigned* rdy = dep + DEP_RDY;
    f32x4 rbs[2][8];
    bool bpre = false;
    int nx_a = -1;
    int cur = jg;
    unsigned tk = 0x3fffffffu, rdv = 0u; bool acq = false;
    if (tid == 0) tk = (unsigned)nbx + xb_add(tkt, 1u);
    bool pup = false; int pslot = 0;
    if (cur < tot && tid < BM) { bool u0; int e0, j0, q0; moe_decode2(cur, totU, ex4, ntm4, u0, e0, j0, q0); const int idx = j0 * BM + tid; nx_a = idx < cnt[e0] ? lists[(size_t)e0 * NTOK + idx] : -1; }
    while (cur < tot) {
        bool up; int e, j, tq; moe_decode2(cur, totU, ex4, ntm4, up, e, j, tq);
        const int tn = 2 * tq + hsel;
        if (pup) asm volatile("s_waitcnt vmcnt(0)" ::: "memory");
        __syncthreads();
        if (tid < BM) rowa[tid] = nx_a;
        if (tid == 0) {
            if (pup) (void)xb_add(&rdy[pslot], 1u);
            misc[0] = (int)tk;
            if (!up) {
                if (!acq) { XB_SPIN(xb_ld(&rdy[e * 72 + j]) < 4u, bar); __builtin_amdgcn_fence(__ATOMIC_ACQUIRE, "agent"); }
                asm volatile("s_waitcnt vmcnt(0)" ::: "memory");
            }
        }
        __syncthreads();
        const int nxt = __builtin_amdgcn_readfirstlane(misc[0]);
        const bool has_next = nxt < tot;
        bool up2 = up; int e2 = e, j2 = j, tq2 = tq;
        if (has_next) moe_decode2(nxt, totU, ex4, ntm4, up2, e2, j2, tq2);
        const int tn2 = 2 * tq2 + hsel;
        if (has_next && tid < BM) { const int idx = j2 * BM + tid; nx_a = idx < cnt[e2] ? lists[(size_t)e2 * NTOK + idx] : -1; }
        if (tid == 0 && has_next && !up2) rdv = xb_ld(&rdy[e2 * 72 + j2]);
        const int th = tid_opaque() & 255;
        const int a0 = rowa[64 * hsel + (th >> 3)], a1 = rowa[64 * hsel + (th >> 3) + 32];
        const size_t eo = (size_t)(layer * NEXP + e), eo2 = (size_t)(layer * NEXP + e2);
        const float* bnext;
        { const int nl = 4 * (th & 31), bwn = nl >> 6, half = (nl >> 5) & 1, c = nl & 31;
          bnext = up2 ? (half ? p.wu : p.wg) + eo2 * D * DEXP + tn2 * 64 + bwn * 32 + c : p.wd + eo2 * DEXP * D + tn2 * 128 + 4 * (th & 31); }
        f32x16 acc[2][2];
        {
            const bf16_t* abase = up ? xn : G; const int ash = up ? 1 : 0, ald = up ? D : DEXP;
            const bf16_t* ap0 = a0 >= 0 ? abase + (size_t)(a0 >> ash) * ald : zrow; const bf16_t* ap1 = a1 >= 0 ? abase + (size_t)(a1 >> ash) * ald : zrow;
            const int nl = 4 * (th & 31), bwn = nl >> 6, half = (nl >> 5) & 1, c = nl & 31;
            const float* bp = up ? (half ? p.wu : p.wg) + eo * D * DEXP + tn * 64 + bwn * 32 + c : p.wd + eo * DEXP * D + tn * 128 + nl;
            gemm_dual(lds, ap0, ap1, bp, up ? DEXP : D, up ? D : DEXP, acc, rbs, bpre, bnext, up2 ? DEXP : D);
        }
        if (tid == 0) {
            acq = false;
            if (has_next && !up2 && rdv >= 4u) { __builtin_amdgcn_fence(__ATOMIC_ACQUIRE, "agent"); acq = true; }
            tk = (unsigned)nbx + xb_add(tkt, 1u);
        }
        if (up) {
            const __amdgpu_buffer_rsrc_t grs = __builtin_amdgcn_make_buffer_rsrc((void*)G, 0, NASG * DEXP * 2, 0x00020000);
            const bool odd = (lane & 4) != 0;
#pragma unroll
            for (int mi = 0; mi < 2; ++mi)
#pragma unroll
                for (int k2 = 0; k2 < 2; ++k2) {
                    unsigned d[2][2];
#pragma unroll
                    for (int s = 0; s < 2; ++s) {
                        const int a4 = 2 * k2 + s; float v[4];
#pragma unroll
                        for (int i = 0; i < 4; ++i) { const float gv = acc[mi][0][4 * a4 + i], uv = acc[mi][1][4 * a4 + i]; v[i] = gv * __builtin_amdgcn_rcpf(1.0f + __expf(-gv)) * uv; }
                        quad_transpose(v[0], v[1], v[2], v[3], lane);
                        d[s][0] = pk2(v[0], v[1]); d[s][1] = pk2(v[2], v[3]);
                    }
                    const unsigned s0 = odd ? d[0][0] : d[1][0], s1 = odd ? d[0][1] : d[1][1];
                    const unsigned r0 = (unsigned)__builtin_amdgcn_ds_swizzle((int)s0, 0x101F), r1 = (unsigned)__builtin_amdgcn_ds_swizzle((int)s1, 0x101F);
                    const unsigned k0 = odd ? d[1][0] : d[0][0], k1 = odd ? d[1][1] : d[0][1];
                    const u32x4 o = odd ? (u32x4){r0, r1, k0, k1} : (u32x4){k0, k1, r0, r1};
                    const int a = rowa[wm * 64 + mi * 32 + 8 * (2 * k2 + (odd ? 1 : 0)) + 4 * hh + (lane & 3)];
                    if (a >= 0) __builtin_amdgcn_raw_buffer_store_b128(o, grs, (unsigned)((a * DEXP + tn * 64 + wn * 32 + (c31 & ~7)) * 2), 0, 16);
                }
        } else {
            int a8[2][4]; float w8[2][4];
#pragma unroll
            for (int mi = 0; mi < 2; ++mi)
#pragma unroll
                for (int a4 = 0; a4 < 4; ++a4) a8[mi][a4] = rowa[wm * 64 + mi * 32 + 8 * a4 + 4 * hh + (lane & 3)];
#pragma unroll
            for (int mi = 0; mi < 2; ++mi)
#pragma unroll
                for (int a4 = 0; a4 < 4; ++a4) w8[mi][a4] = a8[mi][a4] >= 0 ? selw[a8[mi][a4]] : 0.f;
#pragma unroll
            for (int mi = 0; mi < 2; ++mi)
#pragma unroll
                for (int a4 = 0; a4 < 4; ++a4) {
                    const int a = a8[mi][a4];
                    const float w = w8[mi][a4];
#pragma unroll
                    for (int ni = 0; ni < 2; ++ni) {
                        float v0 = acc[mi][ni][4 * a4], v1 = acc[mi][ni][4 * a4 + 1], v2 = acc[mi][ni][4 * a4 + 2], v3 = acc[mi][ni][4 * a4 + 3];
                        quad_transpose(v0, v1, v2, v3, lane);
                        if (a >= 0) *(u32x2*)(Y + (size_t)a * D + tn * 128 + wn * 64 + ni * 32 + (c31 & ~3)) = (u32x2){pk2(w * v0, w * v1), pk2(w * v2, w * v3)};
                    }
                }
        }
        pup = up; pslot = e * 72 + j;
        bpre = has_next;
        cur = nxt;
    }
    if (pup) {
        asm volatile("s_waitcnt vmcnt(0)" ::: "memory");
        __syncthreads();
        if (tid == 0) (void)xb_add(&rdy[pslot], 1u);
    }
}

__global__ void __launch_bounds__(NT) fwd_mega(P p_unused) {
    cg::grid_group grid = cg::this_grid();
    __shared__ __attribute__((aligned(16))) unsigned char lds[LDS_BYTES];
#define KA (*kargs())
#define WSP(T, off) ((T*)(kargs()->ws + (off)))
    if (kargs()->ws == nullptr) grid.sync();
    if (threadIdx.x < 4) ((volatile LAS unsigned*)(lds + LDS_XB))[threadIdx.x] = 0u;
    __syncthreads();
    const XcdBarrier bar = xcd_barrier_post(WSP(unsigned, WS_BAR), (volatile LAS unsigned*)(lds + LDS_XB));
    phase_init(KA, WSP(int, WS_CNT), WSP(f32x2, WS_ROPE), lds, WSP(bf16_t, WS_BTIN), WSP(bf16_t, WS_BTOUT), WSP(bf16_t, WS_RT), WSP(f32x4, WS_SSMT), WSP(bf16_t, WS_ZERO), WSP(bf16_t, WS_VTA), WSP(bf16_t, WS_VTD));
#ifndef PROBE
#define PROBE 0
#endif
#if (PROBE) & 0x4000
    xcd_barrier(bar);
    phase_init(KA, WSP(int, WS_CNT), WSP(f32x2, WS_ROPE), lds, WSP(bf16_t, WS_BTIN), WSP(bf16_t, WS_BTOUT), WSP(bf16_t, WS_RT), WSP(f32x4, WS_SSMT), WSP(bf16_t, WS_ZERO), WSP(bf16_t, WS_VTA), WSP(bf16_t, WS_VTD));
#endif
#define REP(bit) for (int rep_ = 0; rep_ < (((PROBE) >> (bit)) & 1) + 1; ++rep_)
    for (int layer = 0; layer < 2; ++layer) {
        phase_norm(KA, layer == 0 ? 0 : 1, kargs()->attn_g + (size_t)layer * D, WSP(float, WS_H), WSP(bf16_t, WS_XN), WSP(bf16_t, WS_Y));
        xcd_barrier(bar);
#if (PROBE) & 0x8000
        if (layer == 0) { phase_norm(KA, 0, kargs()->attn_g, WSP(float, WS_H), WSP(bf16_t, WS_XN), WSP(bf16_t, WS_Y)); xcd_barrier(bar);
                          phase_norm(KA, 0, kargs()->attn_g, WSP(float, WS_H), WSP(bf16_t, WS_XN), WSP(bf16_t, WS_Y)); xcd_barrier(bar); }
#endif
        REP(0) {
            { pg8::Gemm g{WSP(bf16_t, WS_XN), WSP(bf16_t, WS_BTIN) + (size_t)layer * INW * D, MPAD, INW, D}; pg8::StaticOrder S; S.init(MPAD, INW, (int)gridDim.x, (int)blockIdx.x);
              EpiInProj E{WSP(bf16_t, WS_QKV), WSP(bf16_t, WS_KFA), WSP(bf16_t, WS_KFD), WSP(bf16_t, WS_VTA), WSP(bf16_t, WS_VTD), WSP(f32x2, WS_ROPE)};
              pg8::gemm_phase<EpiInProj, pg8::StaticOrder, true, true>((PG8_LAS unsigned char*)lds, g, S, E); }
        xcd_barrier(bar); }
        REP(1) {
        if (blockIdx.x < NBATCH * SSM_G) {
            float* Sl = (float*)(lds + 86016);
            ssm_pass<false>(KA, layer, WSP(bf16_t, WS_QKV), WSP(bf16_t, WS_YB), Sl, lds, WSP(f32x4, WS_SSMT));
            __syncthreads();
            ssm_pass<true>(KA, layer, WSP(bf16_t, WS_QKV), WSP(bf16_t, WS_YB), Sl, lds, WSP(f32x4, WS_SSMT));
        }
        phase_diff(WSP(bf16_t, WS_QKV), WSP(bf16_t, WS_KFD), WSP(bf16_t, WS_VTD), WSP(bf16_t, WS_DTMP));
        phase_swa(KA, layer, WSP(bf16_t, WS_QKV), WSP(bf16_t, WS_KFA), WSP(bf16_t, WS_VTA), WSP(bf16_t, WS_MIX));
        xcd_barrier(bar); }
        phase_gemm_dense<2>(lds, WSP(bf16_t, WS_YB), SSM_W, kargs()->w_glu + (size_t)layer * SSM_W * SSM_W, SSM_W, nullptr, WSP(bf16_t, WS_MIX), WSP(bf16_t, WS_YB), 0, 1, WSP(bf16_t, WS_ZERO), WSP(unsigned, WS_DEP) + layer * DEP_LAYER + DEP_MX);
        phase_diff_combine(KA, layer, WSP(bf16_t, WS_DTMP), WSP(bf16_t, WS_MIX), WSP(unsigned, WS_DEP) + layer * DEP_LAYER + DEP_MX);
        {
            unsigned* dep = WSP(unsigned, WS_DEP) + layer * DEP_LAYER;
            { pg8::Gemm g{WSP(bf16_t, WS_MIX), WSP(bf16_t, WS_BTOUT) + (size_t)layer * D * D, MPG8, D, D}; pg8::StaticOrder S; S.init(MPG8, D, (int)gridDim.x, (int)blockIdx.x);
              EpiOutProj E{WSP(float, WS_H), layer == 0 ? kargs()->x : nullptr, kargs()->meta, layer == 0 ? nullptr : WSP(bf16_t, WS_Y)};
              if (threadIdx.x == 0) { pg8::Unit u; for (int i = 0; S.next(i, u); ++i) XB_SPIN(xb_ld(&dep[DEP_MX + u.pm]) < 14u, WSP(unsigned, WS_BAR));
                                      __builtin_amdgcn_fence(__ATOMIC_ACQUIRE, "agent"); asm volatile("s_waitcnt vmcnt(0)" ::: "memory"); }
              __syncthreads();
              pg8::gemm_phase<EpiOutProj, pg8::StaticOrder, true, true>((PG8_LAS unsigned char*)lds, g, S, E);
              asm volatile("s_waitcnt vmcnt(0)" ::: "memory");
              __syncthreads();
              if (threadIdx.x == 0) { pg8::Unit u; for (int i = 0; S.next(i, u); ++i) (void)xb_add(&dep[DEP_RT + u.pm], 1u); } }
            phase_gemm_dense<3>(lds, WSP(bf16_t, WS_MIX), D, kargs()->w_out + (size_t)layer * D * D, D, WSP(float, WS_G), nullptr, nullptr, MPG8 / BM, 16, WSP(bf16_t, WS_ZERO), dep + DEP_LO, dep + DEP_MX + MPG8 / 256, WSP(unsigned, WS_BAR));
            __syncthreads();
            phase_router(KA, layer, WSP(float, WS_H), WSP(bf16_t, WS_XN), WSP(float, WS_SELW), WSP(int, WS_LIST), WSP(int, WS_CNT) + layer * NEXP, WSP(bf16_t, WS_RT), lds, WSP(float, WS_G), dep + DEP_RT, dep + DEP_LO, WSP(unsigned, WS_BAR));
        }
        xcd_barrier(bar);
        phase_moe2(KA, layer, lds, WSP(bf16_t, WS_XN), WSP(bf16_t, WS_G), WSP(bf16_t, WS_Y), WSP(float, WS_SELW), WSP(int, WS_LIST), WSP(int, WS_CNT) + layer * NEXP, WSP(bf16_t, WS_ZERO), WSP(unsigned, WS_DEP) + layer * DEP_LAYER, WSP(unsigned, WS_BAR));
        xcd_barrier(bar);
    }
    phase_norm(KA, 2, kargs()->final_g, WSP(float, WS_H), WSP(bf16_t, WS_XN), WSP(bf16_t, WS_Y));
}

extern "C" void kernel_launch(void* const* d_in, const int* in_sizes, int n_in, void* d_out, int out_size, void* d_ws, size_t ws_size, hipStream_t stream) {
    static int grid_blocks = 0;
    if (!grid_blocks) {
        int dev = 0, cus = 0, per_cu = 0;
        (void)hipGetDevice(&dev);
        (void)hipDeviceGetAttribute(&cus, hipDeviceAttributeMultiprocessorCount, dev);
        (void)hipOccupancyMaxActiveBlocksPerMultiprocessor(&per_cu, fwd_mega, NT, 0);
        if (per_cu < 1) fprintf(stderr, "occupancy query reports %d blocks per CU\n", per_cu);
        grid_blocks = cus;
        if (ws_size < WS_END) fprintf(stderr, "workspace too small: %zu < %zu\n", ws_size, (size_t)WS_END);
    }
    (void)hipMemsetAsync((unsigned char*)d_ws + WS_BAR, 0, 16384, stream);
    P p{};
    const float** pp = (const float**)&p;
    for (int i = 0; i < 29; ++i) pp[i] = (const float*)d_in[i];
    p.out = (float*)d_out; p.ws = (unsigned char*)d_ws;
    void* args[] = {&p};
    hipError_t e = hipLaunchCooperativeKernel((void*)fwd_mega, dim3(grid_blocks), dim3(NT), args, 0, stream);
    if (e != hipSuccess) fprintf(stderr, "cooperative launch failed: %s (grid %d)\n", hipGetErrorString(e), grid_blocks);
}
```

```cpp
#include <hip/hip_runtime.h>
#include <hip/hip_cooperative_groups.h>
#include <cstdio>
#include <cstdint>
namespace cg = cooperative_groups;

constexpr int D = 2048, NBATCH = 4, SEQ = 2048, NMETA = 16, LT = SEQ + NMETA, NTOK = NBATCH * LT;
constexpr int INW = 3584;
constexpr int OFF_QA = 0, OFF_KA = 768, OFF_VA = 1024, OFF_US = 1280, OFF_QD = 2048, OFF_KD = 2560, OFF_VD = 3072;
constexpr int SSM_W = 768, SSM_G = 48, SSM_P = 64, SSM_H = 16;
constexpr int NEXP = 32, DEXP = 512, NASG = NTOK * 2;
constexpr float EPS = 1e-5f;
constexpr int NT = 512, NWV = NT / 64;

typedef unsigned short bf16_t;
typedef short bf16x8 __attribute__((ext_vector_type(8)));
typedef float f32x16 __attribute__((ext_vector_type(16)));
typedef float f32x4 __attribute__((ext_vector_type(4)));
typedef float f32x2 __attribute__((ext_vector_type(2)));
typedef unsigned u32x4 __attribute__((ext_vector_type(4)));
typedef unsigned u32x2 __attribute__((ext_vector_type(2)));
typedef __bf16 bf16x2_t __attribute__((ext_vector_type(2)));

struct P {
    const float *x, *meta, *attn_g, *ffn_g, *w_in, *sinks, *lam_re, *lam_im, *b_re, *b_im, *c_re, *c_im, *dskip, *log_dt, *w_glu,
        *lq1, *lk1, *lq2, *lk2, *subln_g, *w_out, *rg_w, *rg_b, *re_w, *re_b, *wg, *wu, *wd, *final_g;
    float* out;
    unsigned char* ws;
};

typedef const P __attribute__((address_space(4))) KP;
__device__ __forceinline__ KP* kargs() { unsigned long long k = (unsigned long long)__builtin_amdgcn_kernarg_segment_ptr(); asm volatile("" : "+s"(k)); return (KP*)k; }

constexpr size_t WS_H = 0;
constexpr size_t WS_XN = WS_H + (size_t)NTOK * D * 4;
constexpr size_t WS_QKV = WS_XN + (size_t)NTOK * D * 2;
constexpr size_t WS_MIX = WS_QKV + (size_t)NTOK * INW * 2;
constexpr size_t WS_YB = WS_MIX + (size_t)NTOK * D * 2;
constexpr size_t WS_G = WS_YB + (size_t)NTOK * SSM_W * 2;
constexpr size_t WS_Y = WS_G + (size_t)NASG * DEXP * 2;
constexpr size_t WS_SELW = WS_Y + (size_t)NASG * D * 2;
constexpr size_t WS_LIST = WS_SELW + (size_t)NASG * 4;
constexpr size_t WS_CNT = WS_LIST + (size_t)NEXP * NTOK * 4;
constexpr size_t WS_ROPE = WS_CNT + 256;
constexpr int NKT = 65;
constexpr size_t WS_KFA = WS_ROPE + (size_t)LT * 32 * 8;
constexpr size_t WS_KFD = WS_KFA + (size_t)NBATCH * 4 * NKT * 2048 * 2;
constexpr size_t WS_VTA = WS_KFD + (size_t)NBATCH * 8 * NKT * 2048 * 2;
constexpr size_t WS_VTD = WS_VTA + (size_t)NBATCH * 4 * NKT * 2048 * 2;
constexpr size_t WS_DTMP = WS_VTD + (size_t)NBATCH * 4 * NKT * 4096 * 2;
constexpr size_t WS_SSMS = WS_DTMP + (size_t)NTOK * 1024 * 2;
constexpr size_t WS_BAR = WS_SSMS + (size_t)NBATCH * SSM_G * 8 * 128 * 4;
constexpr size_t WS_BTIN = WS_BAR + 16384;
constexpr size_t WS_BTOUT = WS_BTIN + (size_t)2 * INW * D * 2;
constexpr size_t WS_RT = WS_BTOUT + (size_t)2 * D * D * 2;
constexpr size_t WS_SSMT = WS_RT + (size_t)2 * 2 * 36 * D * 2;
constexpr size_t WS_ZERO = WS_SSMT + (size_t)3 * 2 * SSM_G * SSM_P * 16;
constexpr int DEP_RDY = 256, DEP_RT = 256 + 32 * 72, DEP_LO = DEP_RT + 32, DEP_MX = DEP_RT + 64, DEP_LAYER = DEP_RT + 128;
constexpr size_t WS_DEP = WS_ZERO + 4096;
constexpr size_t WS_END = WS_DEP + (size_t)2 * DEP_LAYER * 4;

__device__ __forceinline__ float bf2f(bf16_t v) { return __uint_as_float((unsigned)v << 16); }
__device__ __forceinline__ unsigned pk2(float a, float b) { f32x2 v = {a, b}; bf16x2_t r = __builtin_convertvector(v, bf16x2_t); return *(unsigned*)&r; }
__device__ __forceinline__ bf16_t f2bf(float a) { return (bf16_t)(pk2(a, 0.f) & 0xffffu); }
template <int CTRL> __device__ __forceinline__ float dppx(float v) { return __uint_as_float(__builtin_amdgcn_mov_dpp(__float_as_uint(v), CTRL, 0xF, 0xF, true)); }
__device__ __forceinline__ float wave_sum(float v) {
    v += dppx<0xB1>(v); v += dppx<0x4E>(v); v += dppx<0x141>(v); v += dppx<0x140>(v);
    v += __int_as_float(__builtin_amdgcn_ds_swizzle(__float_as_int(v), 0x401F));
    const auto r = __builtin_amdgcn_permlane32_swap(__float_as_uint(v), __float_as_uint(v), false, false);
    return __uint_as_float(r[0]) + __uint_as_float(r[1]);
}
__device__ __forceinline__ float wave_max(float v) {
    v = fmaxf(v, dppx<0xB1>(v)); v = fmaxf(v, dppx<0x4E>(v)); v = fmaxf(v, dppx<0x141>(v)); v = fmaxf(v, dppx<0x140>(v));
    v = fmaxf(v, __int_as_float(__builtin_amdgcn_ds_swizzle(__float_as_int(v), 0x401F)));
    const auto r = __builtin_amdgcn_permlane32_swap(__float_as_uint(v), __float_as_uint(v), false, false);
    return fmaxf(__uint_as_float(r[0]), __uint_as_float(r[1]));
}

__device__ __forceinline__ int tid_opaque() { int t = threadIdx.x; asm volatile("" : "+v"(t)); return t; }
__device__ __forceinline__ float xchg32(float v) {
    const auto r = __builtin_amdgcn_permlane32_swap(__float_as_uint(v), __float_as_uint(v), false, false);
    return __uint_as_float((tid_opaque() & 32) ? r[0] : r[1]);
}
__device__ __forceinline__ int xchg32i(int v) {
    const auto r = __builtin_amdgcn_permlane32_swap((unsigned)v, (unsigned)v, false, false);
    return (int)((tid_opaque() & 32) ? r[0] : r[1]);
}
__device__ __forceinline__ void quad_transpose(float& v0, float& v1, float& v2, float& v3, int lane) {
    const bool o1 = lane & 1, o2 = lane & 2;
    float s01 = o1 ? v0 : v1, s23 = o1 ? v2 : v3;
    float r01 = __uint_as_float(__builtin_amdgcn_mov_dpp(__float_as_uint(s01), 0xB1, 0xF, 0xF, true));
    float r23 = __uint_as_float(__builtin_amdgcn_mov_dpp(__float_as_uint(s23), 0xB1, 0xF, 0xF, true));
    if (o1) { v0 = r01; v2 = r23; } else { v1 = r01; v3 = r23; }
    float s02 = o2 ? v0 : v2, s13 = o2 ? v1 : v3;
    float r02 = __uint_as_float(__builtin_amdgcn_mov_dpp(__float_as_uint(s02), 0x4E, 0xF, 0xF, true));
    float r13 = __uint_as_float(__builtin_amdgcn_mov_dpp(__float_as_uint(s13), 0x4E, 0xF, 0xF, true));
    if (o2) { v0 = r02; v1 = r13; } else { v2 = r02; v3 = r13; }
}


#define XB_TMO      128
#define XB_XCNT(j)  (256  + 64 * (j))
#define XB_XSUB(j)  (1280 + 64 * (j))
#define XB_XGEN(j)  (2304 + 64 * (j))
#define XB_TOP      3328
#define XB_TOPGEN   3392
#define XCD_BAR_WORDS 3456
#define XB_SPIN_CAP (1u << 20)
#define LAS __attribute__((address_space(3)))
__device__ __forceinline__ unsigned xb_ld(unsigned* p)              { return __hip_atomic_load(p, __ATOMIC_RELAXED, __HIP_MEMORY_SCOPE_AGENT); }
__device__ __forceinline__ unsigned xb_add(unsigned* p, unsigned v) { return __hip_atomic_fetch_add(p, v, __ATOMIC_RELAXED, __HIP_MEMORY_SCOPE_AGENT); }
__device__ __forceinline__ unsigned xb_xcc_id() { return (unsigned)__builtin_amdgcn_s_getreg((3 << 11) | 20) & 0xFu; }
#define XB_SPIN(cond, bar) do { unsigned _sp = 0; while (cond) { __builtin_amdgcn_s_sleep(1); \
    if ((++_sp & 255u) == 0u) { if (xb_ld(&(bar)[XB_TMO])) break; if (_sp > XB_SPIN_CAP) { atomicAdd(&(bar)[XB_TMO], 1u); break; } } } } while (0)
struct XcdBarrier { unsigned* bar; unsigned x; volatile LAS unsigned* st; };
__device__ __forceinline__ XcdBarrier xcd_barrier_post(unsigned* bar, volatile LAS unsigned* st) {
    XcdBarrier b; b.bar = bar; b.x = xb_xcc_id(); b.st = st;
    if (threadIdx.x == 0) (void)xb_add(&bar[XB_XCNT(b.x)], 1u);
    return b;
}
__device__ __forceinline__ void xcd_barrier_complete(unsigned* bar, unsigned x, unsigned& nloc, unsigned& nx) {
    const unsigned G = gridDim.x * gridDim.y * gridDim.z;
    unsigned sum, cnt, mine, sp = 0u;
    for (;;) {
        sum = 0u; cnt = 0u; mine = 0u;
#pragma unroll
        for (unsigned j = 0; j < 16; ++j) { const unsigned c = xb_ld(&bar[XB_XCNT(j)]); sum += c; cnt += (c > 0u) ? 1u : 0u; mine = (j == x) ? c : mine; }
        if (sum == G) break;
        __builtin_amdgcn_s_sleep(1);
        if ((++sp & 255u) == 0u) { if (xb_ld(&bar[XB_TMO])) break; if (sp > XB_SPIN_CAP) { atomicAdd(&bar[XB_TMO], 1u); break; } }
    }
    nloc = mine > 0u ? mine : 1u; nx = cnt > 0u ? cnt : 1u;
}
__device__ __forceinline__ void xcd_barrier(const XcdBarrier& b) {
    asm volatile("s_waitcnt vmcnt(0)" ::: "memory");
    __syncthreads();
    if (threadIdx.x == 0) {
        unsigned* bar = b.bar;
        __builtin_amdgcn_s_waitcnt(0);
        unsigned nloc = b.st[0], nx = b.st[1];
        if (nloc == 0u) { xcd_barrier_complete(bar, b.x, nloc, nx); b.st[0] = nloc; b.st[1] = nx; }
        const unsigned old = xb_add(&bar[XB_XSUB(b.x)], 1u);
        const unsigned gen = old / nloc;
        if (old + 1u == (gen + 1u) * nloc) {
            __builtin_amdgcn_fence(__ATOMIC_RELEASE, "agent");
            asm volatile("s_waitcnt vmcnt(0)" ::: "memory");
            const unsigned og = xb_add(&bar[XB_TOP], 1u);
            const unsigned tg = og / nx;
            if (og + 1u == (tg + 1u) * nx) xb_add(&bar[XB_TOPGEN], 1u);
            else XB_SPIN(xb_ld(&bar[XB_TOPGEN]) == tg, bar);
            __builtin_amdgcn_fence(__ATOMIC_ACQUIRE, "agent");
            xb_add(&bar[XB_XGEN(b.x)], 1u);
            asm volatile("s_waitcnt vmcnt(0)" ::: "memory");
        } else {
            XB_SPIN(xb_ld(&bar[XB_XGEN(b.x)]) == gen, bar);
            __builtin_amdgcn_fence(__ATOMIC_ACQUIRE, "agent");
            asm volatile("s_waitcnt vmcnt(0)" ::: "memory");
        }
    }
    __syncthreads();
}

constexpr int MPG8 = 8192;
constexpr int BM = 128, BN = 256, BK = 64;
constexpr int A_STAGE = BM * 128, B_STAGE = BN * 128, STAGE = A_STAGE + B_STAGE;
constexpr int LDS_ROWA = 131072;
constexpr int LDS_PRE = LDS_ROWA + 512;
constexpr int LDS_SX = LDS_PRE + 256;
constexpr int LDS_XB = LDS_SX + NWV * 128 * 4;
constexpr int LDS_BYTES = LDS_XB + 16;

__device__ __forceinline__ int swz(int r, int s) { return r * 128 + ((s ^ (((r >> 1) & 7) ^ ((r >> 4) & 1))) << 4); }

constexpr int GD_A_STAGE = 16384, GD_B_BASE = 32768, GD_B_HALF = 32768;
__device__ __forceinline__ void gemm_dual(unsigned char* lds, const bf16_t* ap0, const bf16_t* ap1, const float* bp, int ldb, int K, f32x16 (&acc)[2][2],
                                          f32x4 (&rb)[2][8], bool bpre, const float* bnext, int ldbn = 0) {
    const int tid = tid_opaque(), lane = tid & 63, th = tid & 255, wave = (tid >> 6) & 3, wm = wave >> 1, wn = wave & 1;
    const int hsel = __builtin_amdgcn_readfirstlane(tid >> 8);
#pragma unroll
    for (int i = 0; i < 2; ++i)
#pragma unroll
        for (int j = 0; j < 2; ++j)
#pragma unroll
            for (int r = 0; r < 16; ++r) acc[i][j][r] = 0.f;
    unsigned char* bst0 = lds + GD_B_BASE + hsel * GD_B_HALF; unsigned char* bst1 = bst0 + 16384;
    const int as = th & 7, arow = 64 * hsel + (th >> 3);
    const int awo0 = swz(arow, as), awo1 = swz(arow + 32, as);
    const int ng = th & 31, kg = th >> 5;
    const int bwo0 = swz(4 * ng + 0, kg), bwo1 = swz(4 * ng + 1, kg), bwo2 = swz(4 * ng + 2, kg), bwo3 = swz(4 * ng + 3, kg);
    const int r31 = lane & 31, hh = lane >> 5;
    const int cl = (hh ^ (((r31 >> 1) & 7) ^ ((r31 >> 4) & 1))) << 4;
    const int aro = (wm * 64 + r31) * 128, bro = (wn * 64 + r31) * 128;
    if (ldbn == 0) ldbn = ldb;
    const float* bpk = bp + (size_t)(kg * 8) * ldb;
    const float* bnk = bnext + (size_t)(kg * 8) * ldbn;
    const bf16_t* a0p = ap0 + as * 8; const bf16_t* a1p = ap1 + as * 8;
    u32x4 ra[2][2];
    const int KT = K / BK;
#define GD_LOADA(S, kt)                                                                            \
    {                                                                                              \
        const int ta = (kt) + hsel < KT ? (kt) + hsel : KT - 1;                                    \
        ra[S][0] = *(const u32x4*)(a0p + ta * BK);                                                 \
        ra[S][1] = *(const u32x4*)(a1p + ta * BK);                                                 \
    }
#define GD_LOADB(S, bq_, ld_)                                                                      \
    {                                                                                              \
        const float* bq = (bq_); const int ld = (ld_);                                             \
        _Pragma("unroll") for (int q = 0; q < 8; ++q) rb[S][q] = *(const f32x4*)(bq + (size_t)q * ld); \
    }
#define GD_LOADBP(S, bq, ld, q0, q1)                                                               \
    { _Pragma("unroll") for (int q = (q0); q < (q1); ++q) rb[S][q] = *(const f32x4*)((bq) + (size_t)q * (ld)); }
#define GD_STORE(S, bst)                                                                           \
    {                                                                                              \
        unsigned char* ast = lds + (((S) + hsel) & 1) * GD_A_STAGE;                                \
        *(u32x4*)(ast + awo0) = ra[S][0]; *(u32x4*)(ast + awo1) = ra[S][1];                        \
        u32x4 w0 = {pk2(rb[S][0][0], rb[S][1][0]), pk2(rb[S][2][0], rb[S][3][0]), pk2(rb[S][4][0], rb[S][5][0]), pk2(rb[S][6][0], rb[S][7][0])}; \
        u32x4 w1 = {pk2(rb[S][0][1], rb[S][1][1]), pk2(rb[S][2][1], rb[S][3][1]), pk2(rb[S][4][1], rb[S][5][1]), pk2(rb[S][6][1], rb[S][7][1])}; \
        u32x4 w2 = {pk2(rb[S][0][2], rb[S][1][2]), pk2(rb[S][2][2], rb[S][3][2]), pk2(rb[S][4][2], rb[S][5][2]), pk2(rb[S][6][2], rb[S][7][2])}; \
        u32x4 w3 = {pk2(rb[S][0][3], rb[S][1][3]), pk2(rb[S][2][3], rb[S][3][3]), pk2(rb[S][4][3], rb[S][5][3]), pk2(rb[S][6][3], rb[S][7][3])}; \
        *(u32x4*)((bst) + bwo0) = w0; *(u32x4*)((bst) + bwo1) = w1; *(u32x4*)((bst) + bwo2) = w2; *(u32x4*)((bst) + bwo3) = w3; \
    }
#define GD_LDF(ast, bst, kk, A0, A1, B0, B1)                                                        \
    { const int so = cl ^ ((kk) << 5);                                                             \
      A0 = *(const bf16x8*)((ast) + aro + so); A1 = *(const bf16x8*)((ast) + aro + 4096 + so);     \
      B0 = *(const bf16x8*)((bst) + bro + so); B1 = *(const bf16x8*)((bst) + bro + 4096 + so); }
#define GD_MF(A0, A1, B0, B1)                                                                       \
    { acc[0][0] = __builtin_amdgcn_mfma_f32_32x32x16_bf16(A0, B0, acc[0][0], 0, 0, 0);              \
      acc[0][1] = __builtin_amdgcn_mfma_f32_32x32x16_bf16(A0, B1, acc[0][1], 0, 0, 0);              \
      acc[1][0] = __builtin_amdgcn_mfma_f32_32x32x16_bf16(A1, B0, acc[1][0], 0, 0, 0);              \
      acc[1][1] = __builtin_amdgcn_mfma_f32_32x32x16_bf16(A1, B1, acc[1][1], 0, 0, 0); }
#define GD_MMA(ast, bst)                                                                           \
    { bf16x8 xa0, xa1, xb0, xb1, ya0, ya1, yb0, yb1;                                               \
      GD_LDF(ast, bst, 0, xa0, xa1, xb0, xb1); GD_LDF(ast, bst, 1, ya0, ya1, yb0, yb1); __builtin_amdgcn_sched_barrier(0); \
      GD_MF(xa0, xa1, xb0, xb1); __builtin_amdgcn_sched_barrier(0);                                \
      GD_LDF(ast, bst, 2, xa0, xa1, xb0, xb1); __builtin_amdgcn_sched_barrier(0);                  \
      GD_MF(ya0, ya1, yb0, yb1); __builtin_amdgcn_sched_barrier(0);                                \
      GD_LDF(ast, bst, 3, ya0, ya1, yb0, yb1); __builtin_amdgcn_sched_barrier(0);                  \
      GD_MF(xa0, xa1, xb0, xb1); GD_MF(ya0, ya1, yb0, yb1); }
#define GD_MMA_IL(ast, bst, S, kta, bq_, ld_)                                                      \
    { bf16x8 xa0, xa1, xb0, xb1, ya0, ya1, yb0, yb1;                                               \
      const float* bq = (bq_); const int ld = (ld_);                                               \
      GD_LDF(ast, bst, 0, xa0, xa1, xb0, xb1); GD_LDF(ast, bst, 1, ya0, ya1, yb0, yb1); __builtin_amdgcn_sched_barrier(0); \
      GD_LOADA(S, kta); __builtin_amdgcn_sched_barrier(0);                                         \
      GD_MF(xa0, xa1, xb0, xb1); __builtin_amdgcn_sched_barrier(0);                                \
      GD_LDF(ast, bst, 2, xa0, xa1, xb0, xb1); GD_LOADBP(S, bq, ld, 4, 6); __builtin_amdgcn_sched_barrier(0); \
      GD_MF(ya0, ya1, yb0, yb1); __builtin_amdgcn_sched_barrier(0);                                \
      GD_LDF(ast, bst, 3, ya0, ya1, yb0, yb1); GD_LOADBP(S, bq, ld, 6, 8); __builtin_amdgcn_sched_barrier(0); \
      GD_MF(xa0, xa1, xb0, xb1); __builtin_amdgcn_sched_barrier(0);                                \
      GD_MF(ya0, ya1, yb0, yb1); }
#define GD_SB __builtin_amdgcn_sched_barrier(0)
#define GD_SLOT_END GD_SB; __syncthreads(); GD_SB
    u32x4 e0 = {0u, 0u, 0u, 0u}, e1 = {0u, 0u, 0u, 0u};
    if (hsel == 1) { e0 = *(const u32x4*)a0p; e1 = *(const u32x4*)a1p; }
    GD_SB;
    if (!bpre) { GD_LOADB(0, bpk, ldb); GD_LOADB(1, bpk + (size_t)BK * ldb, ldb); }
    GD_LOADA(0, 0);
    GD_LOADA(1, 1);
    GD_SB;
    if (hsel == 1) {
        *(u32x4*)(lds + awo0) = e0; *(u32x4*)(lds + awo1) = e1;
        __builtin_amdgcn_s_waitcnt(0xc07f);
        __builtin_amdgcn_s_barrier();
    }
    GD_SB;
    GD_STORE(0, bst0);
    GD_SB; GD_LOADBP(0, (2 < KT ? bpk + (size_t)2 * BK * ldb : bnk), (2 < KT ? ldb : ldbn), 0, 4);
    GD_SLOT_END;
    for (int kt = 0; kt < KT; kt += 2) {
        GD_MMA_IL(lds, bst0, 0, (kt + 2 < KT ? kt + 2 : KT - 2), (kt + 2 < KT ? bpk + (size_t)(kt + 2) * BK * ldb : bnk), (kt + 2 < KT ? ldb : ldbn));
        GD_SLOT_END;
        GD_STORE(1, bst1);
        GD_SB; GD_LOADBP(1, (kt + 3 < KT ? bpk + (size_t)(kt + 3) * BK * ldb : bnk + (size_t)BK * ldbn), (kt + 3 < KT ? ldb : ldbn), 0, 4);
        GD_SLOT_END;
        GD_MMA_IL(lds + GD_A_STAGE, bst1, 1, (kt + 3 < KT ? kt + 3 : KT - 1), (kt + 3 < KT ? bpk + (size_t)(kt + 3) * BK * ldb : bnk + (size_t)BK * ldbn), (kt + 3 < KT ? ldb : ldbn));
        GD_SLOT_END;
        if (kt + 2 < KT) GD_STORE(0, bst0);
        GD_SB; GD_LOADBP(0, (kt + 4 < KT ? bpk + (size_t)(kt + 4) * BK * ldb : bnk), (kt + 4 < KT ? ldb : ldbn), 0, 4);
        GD_SLOT_END;
    }
    if (hsel == 0) __builtin_amdgcn_s_barrier();
    GD_SB;
#undef GD_LOADA
#undef GD_LOADB
#undef GD_STORE
#undef GD_MMA
#undef GD_MMA_IL
#undef GD_LOADBP
#undef GD_LDF
#undef GD_MF
#undef GD_SB
#undef GD_SLOT_END
}


namespace pg8 {
#define PG8_LAS __attribute__((address_space(3)))
typedef unsigned short bf16_t;
typedef short bf16x8 __attribute__((ext_vector_type(8)));
typedef float f32x4 __attribute__((ext_vector_type(4)));
typedef unsigned u32x4 __attribute__((ext_vector_type(4)));
constexpr int BM = 256, BK = 64, HALF = 128, HTB = HALF * BK * 2  , STAGE_BYTES = 8 * HTB, NXCD = 8, WGM = 8;

__host__ __device__ __forceinline__ int lds_byte(int r, int c) { const int st = (r >> 4) * 2 + (c >> 5), rr = r & 15, cc = c & 31, ob = rr * 64 + cc * 2; return st * 1024 + (ob ^ (((ob >> 9) & 1) << 5)); }
__host__ __device__ __forceinline__ void stage_rc(int b, int& R, int& C) { const int st = b / 1024, sb = b % 1024, swz = sb ^ (((sb >> 9) & 1) << 5); R = (st >> 1) * 16 + swz / 64; C = (st & 1) * 32 + (swz % 64) / 2; }
__host__ __device__ __forceinline__ int perm32(int rho) { const int n = rho >> 4, i = rho & 15; return 8 * (i >> 2) + 4 * n + (i & 3); }

struct Unit { int pm, pn; };
struct Gemm { const bf16_t* A; const bf16_t* Bt; int M, N, K; };

struct StaticOrder {
    int nM, nN, nwg, G, c;
    __host__ __device__ void init(int M, int N, int G_, int c_) { nM = M / BM; nN = N / BM; nwg = nM * nN; G = G_; c = c_; }
    __host__ __device__ bool next(int i, Unit& u) const {
        const long L = (long)i * G + c; if (L >= nwg) return false;
        int wgid = (int)L; { const int q = nwg / NXCD, r = nwg % NXCD, xcd = wgid % NXCD, off = wgid / NXCD; wgid = (xcd < r ? xcd * (q + 1) : r * (q + 1) + (xcd - r) * q) + off; }
        const int nig = WGM * nN, gid = wgid / nig, fm = gid * WGM, gsz = (nM - fm) < WGM ? (nM - fm) : WGM;
        u.pm = fm + ((wgid % nig) % gsz); u.pn = (wgid % nig) / gsz; return true;
    }
    __device__ __forceinline__ void a_ready(const Unit&) const {}
    __device__ __forceinline__ void done(const Unit&) const {}
};

template <class Epi, class Sched, bool ALIGN_EPI = false, bool SP2 = false>
__device__ __forceinline__ void gemm_phase(PG8_LAS unsigned char* lds, const Gemm g, const Sched& S, const Epi& E) {
    const int tid = tid_opaque(), wid = __builtin_amdgcn_readfirstlane(tid >> 6), lane = tid & 63, wr = wid >> 2, wc = wid & 3, fr = lane & 15, fq = lane >> 4;
    const int K = g.K, nt = K / BK;
    unsigned voffA[2], voffB[2];
#pragma unroll
    for (int i = 0; i < 2; ++i) { int R, C; stage_rc(tid * 16 + i * 8192, R, C); const int Rb = Epi::PERM ? ((R & ~31) + perm32(R & 31)) : R;
        voffA[i] = (unsigned)(R * K + C) * 2u; voffB[i] = (unsigned)(Rb * K + C) * 2u; }
    const size_t kstep = (size_t)(BK * 2);
    const size_t hstep = (size_t)HALF * K * 2;
    const size_t tstep = 2 * hstep;
    const unsigned ldsw = (unsigned)wid * 1024u;
    const int aoff = lds_byte(wr * 64 + fr, fq * 8), boff = lds_byte(wc * 32 + fr, fq * 8);
#define PG8_SA(b, h) (((b) * 2 + (h)) * HTB)
#define PG8_SB(b, h) ((4 + (b) * 2 + (h)) * HTB)
#define PG8_STAGE(bufoff, gbase, voff) do { _Pragma("unroll") for (int _i = 0; _i < 2; ++_i) \
        __builtin_amdgcn_global_load_lds((const unsigned*)((const char*)(gbase) + (voff)[_i]), (PG8_LAS unsigned*)(lds + (bufoff) + ldsw + _i * 8192), 16, 0, 0); } while (0)
#define PG8_LDA(dst, b, h) do { _Pragma("unroll") for (int m = 0; m < 4; ++m) _Pragma("unroll") for (int k = 0; k < 2; ++k) dst[m][k] = *(const PG8_LAS bf16x8*)(lds + PG8_SA(b, h) + aoff + m * 2048 + k * 1024); } while (0)
#define PG8_LDB(dst, b, h) do { _Pragma("unroll") for (int n = 0; n < 2; ++n) _Pragma("unroll") for (int k = 0; k < 2; ++k) dst[n][k] = *(const PG8_LAS bf16x8*)(lds + PG8_SB(b, h) + boff + n * 2048 + k * 1024); } while (0)
#define PG8_MMA(ai, bj, At, Bt) do { __builtin_amdgcn_s_setprio(1); _Pragma("unroll") for (int m = 0; m < 4; ++m) _Pragma("unroll") for (int n = 0; n < 2; ++n) _Pragma("unroll") for (int k = 0; k < 2; ++k) \
        acc[ai][bj][m][n] = __builtin_amdgcn_mfma_f32_16x16x32_bf16(Bt[n][k], At[m][k], acc[ai][bj][m][n], 0, 0, 0); __builtin_amdgcn_s_setprio(0); } while (0)
#define PG8_WAIT_V(n) asm volatile("s_waitcnt vmcnt(" #n ")" ::: "memory")
#define PG8_WAIT_L(n) asm volatile("s_waitcnt lgkmcnt(" #n ")" ::: "memory")
#define PG8_BAR __builtin_amdgcn_s_barrier()
#define PG8_SCHED __builtin_amdgcn_sched_barrier(0)
    Unit cur, nxt; int ui = 0;
    if (!S.next(0, cur)) return;
    f32x4 acc[2][2][4][2];
#pragma unroll
    for (int a = 0; a < 2; ++a)
#pragma unroll
        for (int b = 0; b < 2; ++b)
#pragma unroll
            for (int m = 0; m < 4; ++m)
#pragma unroll
                for (int n = 0; n < 2; ++n) acc[a][b][m][n] = (f32x4){0.f, 0.f, 0.f, 0.f};
    bf16x8 At[4][2], B0[2][2], B1[2][2];
    const char* cA = (const char*)g.A + (size_t)cur.pm * tstep; const char* cB = (const char*)g.Bt + (size_t)cur.pn * tstep;
    S.a_ready(cur);
    if constexpr (SP2) {
        PG8_STAGE(PG8_SB(0, 0), cB, voffB); PG8_STAGE(PG8_SB(0, 1), cB + hstep, voffB); PG8_STAGE(PG8_SA(0, 0), cA, voffA); PG8_STAGE(PG8_SA(0, 1), cA + hstep, voffA);
        if (wr == 1) PG8_BAR;
        PG8_WAIT_V(2); PG8_BAR;
        PG8_STAGE(PG8_SB(1, 0), cB + kstep, voffB); PG8_STAGE(PG8_SA(1, 0), cA + kstep, voffA); PG8_STAGE(PG8_SB(1, 1), cB + hstep + kstep, voffB);
        PG8_WAIT_V(6); PG8_BAR;
    } else {
        PG8_STAGE(PG8_SB(0, 0), cB, voffB); PG8_STAGE(PG8_SA(0, 0), cA, voffA); PG8_STAGE(PG8_SB(0, 1), cB + hstep, voffB); PG8_STAGE(PG8_SA(0, 1), cA + hstep, voffA);
        if (wr == 1) PG8_BAR;
        PG8_WAIT_V(4); PG8_BAR;
        PG8_STAGE(PG8_SB(1, 0), cB + kstep, voffB); PG8_STAGE(PG8_SA(1, 0), cA + kstep, voffA); PG8_STAGE(PG8_SB(1, 1), cB + hstep + kstep, voffB);
        PG8_WAIT_V(6); PG8_BAR;
    }
    for (;;) {
        const bool has_next = S.next(ui + 1, nxt);
        const char* nA = has_next ? (const char*)g.A + (size_t)nxt.pm * tstep : cA; const char* nB = has_next ? (const char*)g.Bt + (size_t)nxt.pn * tstep : cB;
        for (int t = 0; t < nt; t += 2) {
            const bool last = (t == nt - 2);
            const char* a1 = cA + (size_t)(t + 1) * kstep;
            const char* a2 = last ? nA : cA + (size_t)(t + 2) * kstep; const char* b2 = last ? nB : cB + (size_t)(t + 2) * kstep;
            const char* a3 = a2 + kstep; const char* b3 = b2 + kstep;
            if (last && has_next) S.a_ready(nxt);
            if constexpr (SP2) {
            PG8_LDB(B0, 0, 0); PG8_LDB(B1, 0, 1); PG8_SCHED; PG8_LDA(At, 0, 0); PG8_STAGE(PG8_SA(1, 1), a1 + hstep, voffA);
            PG8_WAIT_V(8); PG8_WAIT_L(0); PG8_BAR; PG8_MMA(0, 0, At, B0); PG8_MMA(0, 1, At, B1); PG8_BAR; PG8_SCHED;
            PG8_LDA(At, 0, 1); PG8_STAGE(PG8_SB(0, 0), b2, voffB); PG8_STAGE(PG8_SB(0, 1), b2 + hstep, voffB); PG8_STAGE(PG8_SA(0, 0), a2, voffA);
            PG8_WAIT_V(8); PG8_WAIT_L(0); PG8_BAR; PG8_MMA(1, 0, At, B0); PG8_MMA(1, 1, At, B1); PG8_BAR; PG8_SCHED;
            PG8_LDB(B0, 1, 0); PG8_LDB(B1, 1, 1); PG8_SCHED; PG8_LDA(At, 1, 0); PG8_STAGE(PG8_SA(0, 1), a2 + hstep, voffA);
            PG8_WAIT_V(8); PG8_WAIT_L(0); PG8_BAR; PG8_MMA(0, 0, At, B0); PG8_MMA(0, 1, At, B1); PG8_BAR; PG8_SCHED;
            PG8_LDA(At, 1, 1); PG8_STAGE(PG8_SB(1, 0), b3, voffB); PG8_STAGE(PG8_SB(1, 1), b3 + hstep, voffB); PG8_STAGE(PG8_SA(1, 0), a3, voffA);
            PG8_WAIT_V(8); PG8_WAIT_L(0); PG8_BAR; PG8_MMA(1, 0, At, B0); PG8_MMA(1, 1, At, B1); PG8_BAR; PG8_SCHED;
            } else {
            PG8_LDB(B0, 0, 0); PG8_SCHED; PG8_LDA(At, 0, 0); PG8_STAGE(PG8_SA(1, 1), a1 + hstep, voffA);
            PG8_WAIT_L(8); PG8_BAR; PG8_WAIT_L(0); PG8_MMA(0, 0, At, B0); PG8_BAR; PG8_SCHED;
            PG8_LDB(B1, 0, 1); PG8_STAGE(PG8_SB(0, 0), b2, voffB);
            PG8_BAR; PG8_WAIT_L(0); PG8_MMA(0, 1, At, B1); PG8_BAR;
            PG8_LDA(At, 0, 1); PG8_STAGE(PG8_SA(0, 0), a2, voffA);
            PG8_BAR; PG8_WAIT_L(0); PG8_MMA(1, 0, At, B0); PG8_BAR; PG8_SCHED;
            PG8_STAGE(PG8_SB(0, 1), b2 + hstep, voffB);
            PG8_WAIT_V(6); PG8_BAR; PG8_MMA(1, 1, At, B1); PG8_BAR;
            PG8_LDB(B0, 1, 0); PG8_SCHED; PG8_LDA(At, 1, 0); PG8_STAGE(PG8_SA(0, 1), a2 + hstep, voffA);
            PG8_WAIT_L(8); PG8_BAR; PG8_WAIT_L(0); PG8_MMA(0, 0, At, B0); PG8_BAR; PG8_SCHED;
            PG8_LDB(B1, 1, 1); PG8_STAGE(PG8_SB(1, 0), b3, voffB);
            PG8_BAR; PG8_WAIT_L(0); PG8_MMA(0, 1, At, B1); PG8_BAR;
            PG8_LDA(At, 1, 1); PG8_STAGE(PG8_SA(1, 0), a3, voffA);
            PG8_BAR; PG8_WAIT_L(0); PG8_MMA(1, 0, At, B0); PG8_BAR; PG8_SCHED;
            PG8_STAGE(PG8_SB(1, 1), b3 + hstep, voffB);
            PG8_WAIT_V(6); PG8_BAR; PG8_MMA(1, 1, At, B1); PG8_BAR;
            }
        }
        if constexpr (ALIGN_EPI) { if (wr == 0) PG8_BAR; }
        if constexpr (!Epi::AFTER_DRAIN) { E(acc, cur, wr, wc, fr, fq); S.done(cur); }
        if (!has_next) break;
#pragma unroll
        for (int a = 0; a < 2; ++a)
#pragma unroll
            for (int b = 0; b < 2; ++b)
#pragma unroll
                for (int m = 0; m < 4; ++m)
#pragma unroll
                    for (int n = 0; n < 2; ++n) acc[a][b][m][n] = (f32x4){0.f, 0.f, 0.f, 0.f};
        cur = nxt; cA = nA; cB = nB; ++ui;
        if constexpr (ALIGN_EPI) { if (wr == 1) PG8_BAR; }
    }
    PG8_WAIT_V(0);
    if constexpr (!ALIGN_EPI) { if (wr == 0) PG8_BAR; }
    PG8_BAR;
    if constexpr (Epi::AFTER_DRAIN) { E.fused(acc, cur, wr, wc, fr, fq, lds, wid, lane); S.done(cur); }
#undef PG8_SA
#undef PG8_SB
#undef PG8_STAGE
#undef PG8_LDA
#undef PG8_LDB
#undef PG8_MMA
#undef PG8_WAIT_V
#undef PG8_WAIT_L
#undef PG8_BAR
#undef PG8_SCHED
}
}

__device__ __forceinline__ int vt_pos(int k) { return (k & 3) | (((k >> 3) & 1) << 2) | (((k >> 2) & 1) << 3); }

struct EpiInProj {
    static constexpr bool PERM = false, AFTER_DRAIN = false;
    bf16_t* qkv; bf16_t* kfa; bf16_t* kfd; bf16_t* vta; bf16_t* vtd; const f32x2* rope;
    __device__ __forceinline__ void operator()(const pg8::f32x4 (&acc)[2][2][4][2], const pg8::Unit& u, int wr, int wc, int fr, int fq) const {
        const int cw = 16 * (wc & 1) + 4 * fq;
        pg8::f32x4 rc[2][4][2];
        { const int cb0 = 64 * (4 * u.pn + (wc >> 1)), cb1 = cb0 + 128;
          if (cb0 < 1024 || (cb0 >= 2048 && cb0 < 3072) || cb1 < 1024 || (cb1 >= 2048 && cb1 < 3072)) {
#pragma unroll
              for (int ai = 0; ai < 2; ++ai)
#pragma unroll
                  for (int m = 0; m < 4; ++m) {
                      const int row = 256 * u.pm + 128 * ai + 64 * wr + 16 * m + fr;
                      const pg8::f32x4* rp = (const pg8::f32x4*)(rope + (size_t)(row % LT) * 32 + cw);
                      rc[ai][m][0] = rp[0]; rc[ai][m][1] = rp[1];
                  }
          } }
#pragma unroll
        for (int bj = 0; bj < 2; ++bj) {
            const int cb = 64 * (4 * u.pn + 2 * bj + (wc >> 1));
            const bool is_rope = cb < 1024 || (cb >= 2048 && cb < 3072);
            const bool is_v = (cb >= OFF_VA && cb < OFF_US) || cb >= OFF_VD;
            const bool is_k = (cb >= OFF_KA && cb < OFF_VA) || (cb >= OFF_KD && cb < OFF_VD);
#pragma unroll
            for (int ai = 0; ai < 2; ++ai)
#pragma unroll
                for (int m = 0; m < 4; ++m) {
                    const int row = 256 * u.pm + 128 * ai + 64 * wr + 16 * m + fr;
                    if (row >= NTOK) continue;
                    pg8::f32x4 v0 = acc[ai][bj][m][0], v1 = acc[ai][bj][m][1];
                    const int b = row / LT, pos = row % LT, kt = pos >> 5;
                    if (is_v) {
                        const int s2 = (pos >> 4) & 1, qd = fr & 3, g4 = fr >> 2, hv = g4 & 1, j0 = 4 * (g4 >> 1);
                        bf16_t* dst = (cb < OFF_US) ? vta + ((((size_t)(b * 4 + (cb - OFF_VA) / 64) * NKT + kt) * 2 + 0) * 2 + s2) * 512 + (size_t)(cw + qd + 32 * hv) * 8 + j0
                                                    : vtd + ((((size_t)(b * 4 + (cb - OFF_VD) / 128) * NKT + kt) * 4 + (((cb - OFF_VD) & 127) >> 5)) * 2 + s2) * 512 + (size_t)(cw + qd + 32 * hv) * 8 + j0;
                        { float a0 = v0[0], a1 = v0[1], a2 = v0[2], a3 = v0[3]; quad_transpose(a0, a1, a2, a3, fr); *(u32x2*)dst = (u32x2){pk2(a0, a1), pk2(a2, a3)}; }
                        { float a0 = v1[0], a1 = v1[1], a2 = v1[2], a3 = v1[3]; quad_transpose(a0, a1, a2, a3, fr); *(u32x2*)(dst + 1024) = (u32x2){pk2(a0, a1), pk2(a2, a3)}; }
                    } else {
                        if (is_rope) {
                            const pg8::f32x4 c01 = rc[ai][m][0], c23 = rc[ai][m][1];
                            const float cs[4] = {c01[0], c01[2], c23[0], c23[2]}, sn[4] = {c01[1], c01[3], c23[1], c23[3]};
#pragma unroll
                            for (int e = 0; e < 4; ++e) { const float x1 = v0[e], x2 = v1[e]; v0[e] = x1 * cs[e] - x2 * sn[e]; v1[e] = x2 * cs[e] + x1 * sn[e]; }
                        }
                        const u32x2 w0 = {pk2(v0[0], v0[1]), pk2(v0[2], v0[3])}, w1 = {pk2(v1[0], v1[1]), pk2(v1[2], v1[3])};
                        if (is_k) {
                            bf16_t* kb = (cb < OFF_VA) ? kfa + ((size_t)(b * 4 + (cb - OFF_KA) / 64) * NKT + kt) * 2048 : kfd + ((size_t)(b * 8 + (cb - OFF_KD) / 64) * NKT + kt) * 2048;
                            bf16_t* kp = kb + (size_t)(cw >> 4) * 512 + (size_t)((pos & 31) + 32 * ((cw >> 3) & 1)) * 8 + (cw & 7);
                            *(u32x2*)kp = w0; *(u32x2*)(kp + 1024) = w1;
                        } else {
                            bf16_t* op = qkv + (size_t)row * INW + cb + cw;
                            *(u32x2*)op = w0; *(u32x2*)(op + 32) = w1;
                        }
                    }
                }
        }
    }
};
struct EpiOutProj {
    static constexpr bool PERM = false, AFTER_DRAIN = false;
    float* h; const float* x; const float* meta;
    __device__ __forceinline__ void operator()(const pg8::f32x4 (&acc)[2][2][4][2], const pg8::Unit& u, int wr, int wc, int fr, int fq) const {
        const __amdgpu_buffer_rsrc_t hrs = __builtin_amdgcn_make_buffer_rsrc((void*)h, 0, NTOK * D * 4, 0x00020000);
#pragma unroll
        for (int ai = 0; ai < 2; ++ai) {
            pg8::f32x4 r[4][2][2];
#pragma unroll
            for (int m = 0; m < 4; ++m) {
                const int row = 256 * u.pm + 128 * ai + 64 * wr + 16 * m + fr, co = 256 * u.pn + 32 * wc + 4 * fq;
                const float* sr = h + (size_t)row * D + co;
                if (x) { const int b = row / LT, i = row % LT; sr = (i < NMETA ? meta + (size_t)i * D : x + ((size_t)b * SEQ + (i - NMETA)) * D) + co; }
#pragma unroll
                for (int bj = 0; bj < 2; ++bj)
#pragma unroll
                    for (int n = 0; n < 2; ++n) r[m][bj][n] = *(const pg8::f32x4*)(sr + 128 * bj + 16 * n);
            }
#pragma unroll
            for (int m = 0; m < 4; ++m) {
                const int row = 256 * u.pm + 128 * ai + 64 * wr + 16 * m + fr, co = 256 * u.pn + 32 * wc + 4 * fq;
#pragma unroll
                for (int bj = 0; bj < 2; ++bj)
#pragma unroll
                    for (int n = 0; n < 2; ++n) { const pg8::f32x4 o = r[m][bj][n] + acc[ai][bj][m][n];
                        __builtin_amdgcn_raw_buffer_store_b128(*(const u32x4*)&o, hrs, (unsigned)((row * D + co + 128 * bj + 16 * n) * 4), 0, 16); }
            }
        }
    }
};
constexpr int MPAD = 8448;

__device__ __forceinline__ void transpose_item(const float* W, int K, int N, bf16_t* WT, bool swap45, float* scr, int item, int tid) {
    const int nblk = N / 64, kb = item / nblk, nb = item % nblk, k0 = kb * 64, n0 = nb * 64;
#pragma unroll
    for (int i = 0; i < 8; ++i) { const int r = (tid >> 6) + 8 * i, c = tid & 63; scr[r * 65 + c] = W[(size_t)(k0 + r) * N + n0 + c]; }
    __syncthreads();
    {
        const int n = tid >> 3, kc = tid & 7;
        const float* s = scr + (8 * kc) * 65 + n;
        const int np = swap45 ? ((n & 15) | ((n & 16) << 1) | ((n & 32) >> 1)) : n;
        *(u32x4*)(WT + (size_t)(n0 + np) * K + k0 + 8 * kc) = (u32x4){pk2(s[0], s[65]), pk2(s[2 * 65], s[3 * 65]), pk2(s[4 * 65], s[5 * 65]), pk2(s[6 * 65], s[7 * 65])};
    }
    __syncthreads();
}

__device__ __forceinline__ void phase_init(KP& p, int* cnt, f32x2* rope, unsigned char* lds, bf16_t* btin, bf16_t* btout, bf16_t* rtab, f32x4* ssmt, bf16_t* zrow, bf16_t* vfa_, bf16_t* vfd_) {
    if (blockIdx.x == 0 && threadIdx.x < 2 * NEXP) cnt[threadIdx.x] = 0;
    if (blockIdx.x == 1) ((unsigned long long*)zrow)[threadIdx.x] = 0ull;
    for (int e = blockIdx.x * NT + threadIdx.x; e < 2 * DEP_LAYER; e += gridDim.x * NT) ((unsigned*)(p.ws + WS_DEP))[e] = 0u;
    for (int e = blockIdx.x * NT + threadIdx.x; e < LT * 32; e += gridDim.x * NT) {
        const int j = e & 31, i = e >> 5;
        const float inv = powf(10000.0f, -(float)j / 32.0f);
        const float ang = (float)i * inv;
        rope[e] = (f32x2){cosf(ang), sinf(ang)};
    }
    for (int e = blockIdx.x * NT + threadIdx.x; e < NBATCH * 4 * (2 + 4) * 64; e += gridDim.x * NT) {
        const int lane_ = e & 63, q = e >> 6, bh = q / 6, dq = q % 6;
        bf16_t* dst = dq < 2 ? vfa_ + ((((size_t)bh * NKT + 64) * 2 + dq) * 2 + 1) * 512 + lane_ * 8 : vfd_ + ((((size_t)bh * NKT + 64) * 4 + (dq - 2)) * 2 + 1) * 512 + lane_ * 8;
        *(u32x4*)dst = (u32x4){0u, 0u, 0u, 0u};
    }
    for (int e = blockIdx.x * NT + threadIdx.x; e < 2 * SSM_G * SSM_P; e += gridDim.x * NT) {
        const float dt = expf(p.log_dt[e / SSM_P]);
        const float lr = p.lam_re[e], li = p.lam_im[e];
        const float mag = expf(lr * dt);
        const float ar = mag * cosf(li * dt), ai = mag * sinf(li * dt);
        const float den = lr * lr + li * li, nr = ar - 1.0f;
        ssmt[e] = (f32x4){ar, ai, (nr * lr + ai * li) / den, (ai * lr - nr * li) / den};
        const float a2r = ar * ar - ai * ai, a2i = 2.0f * ar * ai;
        ssmt[2 * SSM_G * SSM_P + e] = (f32x4){a2r, a2i, a2r * ar - a2i * ai, a2r * ai + a2i * ar};
        float xr = a2r * a2r - a2i * a2i, xi = 2.0f * a2r * a2i;
        const float a4r = xr, a4i = xi;
        for (int q = 0; q < 6; ++q) { const float nr2 = xr * xr - xi * xi, ni2 = 2.0f * xr * xi; xr = nr2; xi = ni2; }
        ssmt[4 * SSM_G * SSM_P + e] = (f32x4){a4r, a4i, xr, xi};
    }
    for (int e = blockIdx.x * NT + threadIdx.x; e < 2 * 36 * D; e += gridDim.x * NT) {
        const int k = e % D, c = (e / D) % 36, layer = e / (36 * D);
        const float w = (c < 32 ? p.re_w[((size_t)layer * D + k) * 32 + c] : p.rg_w[((size_t)layer * D + k) * 4 + (c - 32)]) * p.ffn_g[layer * D + k];
        const bf16_t hi = f2bf(w);
        const size_t ix = c < 32 ? (((size_t)(k >> 4) * 64 + c + 32 * ((k >> 3) & 1)) * 8 + (k & 7)) : ((size_t)c * D + k);
        rtab[(size_t)(layer * 2 + 0) * 36 * D + ix] = hi;
        rtab[(size_t)(layer * 2 + 1) * 36 * D + ix] = f2bf(w - bf2f(hi));
    }
    constexpr int I_IN = (D / 64) * (INW / 64), I_OUT = (D / 64) * (D / 64);
    const int tid = tid_opaque();
    for (int it = blockIdx.x; it < 2 * (I_IN + I_OUT); it += gridDim.x) {
        const int layer = it / (I_IN + I_OUT), r = it % (I_IN + I_OUT);
        if (r < I_IN) transpose_item(p.w_in + (size_t)layer * D * INW, D, INW, btin + (size_t)layer * INW * D, true, (float*)lds, r, tid);
        else transpose_item(p.w_out + (size_t)layer * D * D, D, D, btout + (size_t)layer * D * D, false, (float*)lds, r - I_IN, tid);
    }
}

__device__ __forceinline__ void phase_norm(KP& p, int mode, const float* g, float* h, bf16_t* xn, const bf16_t* Y) {
    const int tidq = tid_opaque(), lane = tidq & 63, gw = (blockIdx.x * NT + tidq) >> 6, nw = (gridDim.x * NT) >> 6;
    float4 gg8[8];
#pragma unroll
    for (int j = 0; j < 8; ++j) gg8[j] = *(const float4*)(g + j * 256 + lane * 4);
    float4 na[8]; u32x2 nc0[8], nc1[8];
#define NORM_LOAD(tt)                                                                              \
    {                                                                                              \
        const int tl = (tt) < NTOK ? (tt) : NTOK - 1;             \
        const int bl = tl / LT, il = tl % LT;                                                      \
        if (mode == 0) {                                                                           \
            const float* src = (il < NMETA) ? p.meta + (size_t)il * D : p.x + ((size_t)bl * SEQ + (il - NMETA)) * D; \
            _Pragma("unroll") for (int j = 0; j < 8; ++j) na[j] = *(const float4*)(src + j * 256 + lane * 4); \
        } else {                                                                                   \
            const bf16_t* y0 = Y + (size_t)(2 * tl) * D; const bf16_t* y1 = y0 + D; const float* hr = h + (size_t)tl * D; \
            _Pragma("unroll") for (int j = 0; j < 8; ++j) { na[j] = *(const float4*)(hr + j * 256 + lane * 4); nc0[j] = *(const u32x2*)(y0 + j * 256 + lane * 4); nc1[j] = *(const u32x2*)(y1 + j * 256 + lane * 4); } \
        }                                                                                          \
    }
    NORM_LOAD(gw);
    for (int t = gw; t < NTOK; t += nw) {
        const int b = t / LT, i = t % LT;
        float4 v[8];
        if (mode == 0) {
#pragma unroll
            for (int j = 0; j < 8; ++j) v[j] = na[j];
        } else {
#pragma unroll
            for (int j = 0; j < 8; ++j) {
                const float4 a = na[j]; const u32x2 c0 = nc0[j], c1 = nc1[j];
                v[j] = make_float4(a.x + __uint_as_float(c0[0] << 16) + __uint_as_float(c1[0] << 16), a.y + __uint_as_float(c0[0] & 0xffff0000u) + __uint_as_float(c1[0] & 0xffff0000u),
                                   a.z + __uint_as_float(c0[1] << 16) + __uint_as_float(c1[1] << 16), a.w + __uint_as_float(c0[1] & 0xffff0000u) + __uint_as_float(c1[1] & 0xffff0000u));
            }
        }
        NORM_LOAD(t + nw);
        float ss = 0.f;
#pragma unroll
        for (int j = 0; j < 8; ++j) ss += v[j].x * v[j].x + v[j].y * v[j].y + v[j].z * v[j].z + v[j].w * v[j].w;
        ss = wave_sum(ss);
        const float rs = rsqrtf(ss * (1.0f / D) + EPS);
        if (mode != 2) {
            const bool wr_h = (mode != 0) || (t >= MPG8);
#pragma unroll
            for (int j = 0; j < 8; ++j) {
                if (wr_h) *(float4*)(h + (size_t)t * D + j * 256 + lane * 4) = v[j];
                const float4 gg = gg8[j];
                *(u32x2*)(xn + (size_t)t * D + j * 256 + lane * 4) = (u32x2){pk2(v[j].x * rs * gg.x, v[j].y * rs * gg.y), pk2(v[j].z * rs * gg.z, v[j].w * rs * gg.w)};
            }
        } else if (i >= NMETA) {
            float* dst = p.out + ((size_t)b * SEQ + (i - NMETA)) * D;
#pragma unroll
            for (int j = 0; j < 8; ++j) {
                const float4 gg = gg8[j];
                *(float4*)(dst + j * 256 + lane * 4) = make_float4(v[j].x * rs * gg.x, v[j].y * rs * gg.y, v[j].z * rs * gg.z, v[j].w * rs * gg.w);
            }
        }
    }
#undef NORM_LOAD
}

template <int DVT, bool WINDOW>
__device__ __forceinline__ void attn_core(const bf16_t* qrow, const bf16_t* kfr, const bf16_t* vfr, int qi, int kt0, int kt1, int lane, float& m, float& l, f32x16 (&oT)[DVT]) {
    const int r31 = lane & 31, hh = lane >> 5;
    bf16x8 qf[4];
#pragma unroll
    for (int kk = 0; kk < 4; ++kk) {
        const u32x4 qv = *(const u32x4*)(qrow + kk * 16 + 8 * hh);
        u32x4 qs;
#pragma unroll
        for (int j = 0; j < 4; ++j) qs[j] = pk2(__uint_as_float(qv[j] << 16) * 0.18033688011112042f, __uint_as_float(qv[j] & 0xffff0000u) * 0.18033688011112042f);
        qf[kk] = *(bf16x8*)&qs;
    }
    m = -1e30f; l = 0.f;
#pragma unroll
    for (int dt = 0; dt < DVT; ++dt)
#pragma unroll
        for (int r = 0; r < 16; ++r) oT[dt][r] = 0.f;
    bf16x8 kfA[4], kfB[4], vfA[DVT][2], vfB[DVT][2];
#define ATT_LOAD(KF, VF, kt_)                                                                       \
    {                                                                                              \
        const bf16_t* kp = kfr + ((size_t)(kt_) * 256 + lane) * 8;                                 \
        _Pragma("unroll") for (int kk = 0; kk < 4; ++kk) KF[kk] = *(const bf16x8*)(kp + kk * 512); \
        const bf16_t* vp = vfr + ((size_t)(kt_) * (DVT * 128) + lane) * 8;                         \
        _Pragma("unroll") for (int dt = 0; dt < DVT; ++dt)                                         \
            _Pragma("unroll") for (int s2 = 0; s2 < 2; ++s2) VF[dt][s2] = *(const bf16x8*)(vp + (dt * 2 + s2) * 512); \
    }
#define ATT_TILE(KF, VF, kt_)                                                                       \
    {                                                                                              \
        f32x16 s;                                                                                  \
        _Pragma("unroll") for (int r = 0; r < 16; ++r) s[r] = 0.f;                                 \
        _Pragma("unroll") for (int kk = 0; kk < 4; ++kk) s = __builtin_amdgcn_mfma_f32_32x32x16_bf16(KF[kk], qf[kk], s, 0, 0, 0); \
        float mx = -1e30f;                                                                         \
        const bool edge = ((kt_) == kt1) || (WINDOW && (kt_) == kt0);     \
        float rs = 0.f;                                                                            \
        float pr[16];                                                                              \
        float mn;                                                                                  \
        bool grow;        \
        if (edge) {                                                                                \
            _Pragma("unroll") for (int r = 0; r < 16; ++r) {                                       \
                const int key = (kt_) * 32 + (r & 3) + 8 * (r >> 2) + 4 * hh;                      \
                const bool ok = (key <= qi) && (!WINDOW || (qi - key) < 128);                      \
                s[r] = ok ? s[r] : -1e30f;                                                         \
                mx = fmaxf(mx, s[r]);                                                              \
            }                                                                                      \
            mx = fmaxf(mx, xchg32(mx));                                                    \
            grow = __any(mx > m + 8.0f);                                                           \
            mn = grow ? fmaxf(m, mx) : m;                                                          \
            _Pragma("unroll") for (int r = 0; r < 16; ++r) { pr[r] = (s[r] > -1e29f) ? __builtin_amdgcn_exp2f(s[r] - mn) : 0.f; rs += pr[r]; } \
        } else {                                                                                   \
            _Pragma("unroll") for (int r = 0; r < 16; ++r) mx = fmaxf(mx, s[r]);                   \
            mx = fmaxf(mx, xchg32(mx));                                                    \
            grow = __any(mx > m + 8.0f);                                                           \
            mn = grow ? fmaxf(m, mx) : m;                                                          \
            _Pragma("unroll") for (int r = 0; r < 16; ++r) { pr[r] = __builtin_amdgcn_exp2f(s[r] - mn); rs += pr[r]; } \
        }                                                                                          \
        if (grow) {                                                                                \
            const float alpha = __builtin_amdgcn_exp2f(m - mn);                                    \
            l *= alpha;                                                                            \
            _Pragma("unroll") for (int dt = 0; dt < DVT; ++dt)                                     \
                _Pragma("unroll") for (int r = 0; r < 16; ++r) oT[dt][r] *= alpha;                 \
        }                                                                                          \
        l += rs; m = mn;                                                                           \
        u32x4 pa = {pk2(pr[0], pr[1]), pk2(pr[2], pr[3]), pk2(pr[4], pr[5]), pk2(pr[6], pr[7])};   \
        u32x4 pb = {pk2(pr[8], pr[9]), pk2(pr[10], pr[11]), pk2(pr[12], pr[13]), pk2(pr[14], pr[15])}; \
        const bf16x8 p0 = *(bf16x8*)&pa, p1 = *(bf16x8*)&pb;                                       \
        _Pragma("unroll") for (int dt = 0; dt < DVT; ++dt) {                                       \
            oT[dt] = __builtin_amdgcn_mfma_f32_32x32x16_bf16(VF[dt][0], p0, oT[dt], 0, 0, 0);      \
            oT[dt] = __builtin_amdgcn_mfma_f32_32x32x16_bf16(VF[dt][1], p1, oT[dt], 0, 0, 0);      \
        }                                                                                          \
    }
    ATT_LOAD(kfA, vfA, kt0);
    for (int kt = kt0; kt <= kt1; kt += 2) {
        { const int kn = kt + 1 <= kt1 ? kt + 1 : kt1; ATT_LOAD(kfB, vfB, kn); }
        __builtin_amdgcn_sched_barrier(0);
        ATT_TILE(kfA, vfA, kt);
        if (kt + 1 > kt1) break;
        { const int kn = kt + 2 <= kt1 ? kt + 2 : kt1; ATT_LOAD(kfA, vfA, kn); }
        __builtin_amdgcn_sched_barrier(0);
        ATT_TILE(kfB, vfB, kt + 1);
    }
#undef ATT_LOAD
#undef ATT_TILE
    l += xchg32(l);
}

__device__ __forceinline__ void phase_swa(KP& p, int layer, const bf16_t* qkv, const bf16_t* kfa, const bf16_t* vta, bf16_t* mix) {
    const int tidq = tid_opaque(), lane = tidq & 63, wv = tidq >> 6;
    int it0, itn;
    if ((int)blockIdx.x >= NBATCH * SSM_G) { it0 = 0; itn = 0; }
    else { const int q = (wv < 4 ? wv : 4 + ((wv - 3) & 3)) * (NBATCH * SSM_G) + (int)blockIdx.x;
           if (q >= 1056) { it0 = 5 * (q - 1056); itn = 5; } else if (q >= 336) { it0 = 2400 + (q - 336); itn = 1; } else { it0 = 0; itn = 0; } }
    const int itend = it0 + itn < NBATCH * 12 * 65 ? it0 + itn : NBATCH * 12 * 65;
    const int r31 = lane & 31, hh = lane >> 5;
    for (int it = it0; it < itend; ++it) {
        const int qb = it % 65, hq = (it / 65) % 12, b = it / (65 * 12), kvh = hq / 3;
        const int qi = qb * 32 + r31, qr = qi < LT ? qi : LT - 1;
        const bf16_t* qrow = qkv + (size_t)(b * LT + qr) * INW + OFF_QA + hq * 64;
        const bf16_t* kbase = kfa + (size_t)(b * 4 + kvh) * NKT * 2048;
        const bf16_t* vT = vta + (size_t)(b * 4 + kvh) * NKT * 2048;
        float m, l; f32x16 oT[2];
        const float sink = p.sinks[layer * 12 + hq] * 1.4426950408889634f;
        attn_core<2, true>(qrow, kbase, vT, qi, qb >= 4 ? qb - 4 : 0, qb, lane, m, l, oT);
        const float M = fmaxf(m, sink), alpha = __builtin_amdgcn_exp2f(m - M);
        const float inv = alpha / (l * alpha + __builtin_amdgcn_exp2f(sink - M));
        if (qi < LT) {
            bf16_t* op = mix + (size_t)(b * LT + qi) * D + hq * 64 + 4 * hh;
#pragma unroll
            for (int dt = 0; dt < 2; ++dt)
#pragma unroll
                for (int a = 0; a < 4; ++a)
                    *(u32x2*)(op + dt * 32 + 8 * a) = (u32x2){pk2(oT[dt][4 * a] * inv, oT[dt][4 * a + 1] * inv), pk2(oT[dt][4 * a + 2] * inv, oT[dt][4 * a + 3] * inv)};
        }
    }
}

__device__ __forceinline__ void phase_diff(const bf16_t* qkv, const bf16_t* kfd, const bf16_t* vtd, bf16_t* dtmp) {
    const int tidq = tid_opaque(), lane = tidq & 63, nw = (gridDim.x * NT) >> 6;
    const int wv = tidq >> 6;
    const bool freeb = (int)blockIdx.x >= NBATCH * SSM_G;
    const int ws = wv < 4 ? wv : 4 + ((wv - 3) & 3);
    const int gw = freeb ? ((int)blockIdx.x - NBATCH * SSM_G) * NWV + wv : 1024 + ws * (NBATCH * SSM_G) + (int)blockIdx.x;
    const int ilim = freeb ? 1024 : NBATCH * 4 * 2 * 65, istep = freeb ? 512 : 4096;
    (void)nw;
    const int r31 = lane & 31, hh = lane >> 5;
    for (int ii = gw; ii < ilim; ii += istep) {
        const int it = ii < 512 ? ii : (ii < 1024 ? 2591 - ii : ii - 512);
        const int qb = 64 - it / 32, sub = it & 1, H = (it >> 1) & 3, b = (it >> 3) & 3;
        const int qi = qb * 32 + r31, qr = qi < LT ? qi : LT - 1;
        const bf16_t* qrow = qkv + (size_t)(b * LT + qr) * INW + OFF_QD + H * 128 + sub * 64;
        const bf16_t* kbase = kfd + (size_t)(b * 8 + H * 2 + sub) * NKT * 2048;
        const bf16_t* vT = vtd + (size_t)(b * 4 + H) * NKT * 4096;
        float m, l; f32x16 oT[4];
        attn_core<4, false>(qrow, kbase, vT, qi, 0, qb, lane, m, l, oT);
        const float inv = 1.0f / l;
        if (qi < LT) {
            bf16_t* op = dtmp + (size_t)(b * LT + qi) * 1024 + H * 256 + sub * 128 + 4 * hh;
#pragma unroll
            for (int dt = 0; dt < 4; ++dt)
#pragma unroll
                for (int a = 0; a < 4; ++a)
                    *(u32x2*)(op + dt * 32 + 8 * a) = (u32x2){pk2(oT[dt][4 * a] * inv, oT[dt][4 * a + 1] * inv), pk2(oT[dt][4 * a + 2] * inv, oT[dt][4 * a + 3] * inv)};
        }
    }
}

__device__ __forceinline__ void phase_diff_combine(KP& p, int layer, const bf16_t* dtmp, bf16_t* mix, unsigned* pubc) {
    const int tidq = tid_opaque(), lane = tidq & 63, w = tidq >> 6, q = lane >> 4, l16 = lane & 15;
    const float lam_init = 0.8f - 0.6f * expf(-0.3f * (float)layer);
    const float d1 = wave_sum(p.lq1[layer * 64 + lane] * p.lk1[layer * 64 + lane]);
    const float d2 = wave_sum(p.lq2[layer * 64 + lane] * p.lk2[layer * 64 + lane]);
    const float lam = expf(d1) - expf(d2) + lam_init;
    const f32x4 ga = *(const f32x4*)(p.subln_g + layer * 128 + 8 * l16), gb = *(const f32x4*)(p.subln_g + layer * 128 + 8 * l16 + 4);
    const __amdgpu_buffer_rsrc_t mrs = __builtin_amdgcn_make_buffer_rsrc((void*)mix, 0, NTOK * D * 2, 0x00020000);
    const int nglu = ((NTOK + BM - 1) / BM) * (SSM_W / 256);
    const int b0 = (int)gridDim.x > nglu ? nglu : 0, nb = (int)gridDim.x - b0;
    for (int blk = (int)blockIdx.x - b0; blk >= 0 && blk < MPG8 / 32; blk += nb) {
        const bool extra = blk < NTOK - MPG8;
        u32x4 a0[5], a1[5];
        int tk[5];
#pragma unroll
        for (int u = 0; u < 5; ++u) {
            const int i = w * 16 + u * 4 + q;
            const int t = u < 4 ? blk * 32 + (i >> 2) : MPG8 + blk, H = u < 4 ? (i & 3) : q;
            tk[u] = t * 4 + H;
            const bool on = u < 4 || (extra && w == 0);
            const bf16_t* src = dtmp + (size_t)(on ? t : blk * 32) * 1024 + H * 256 + 8 * l16;
            a0[u] = *(const u32x4*)src; a1[u] = *(const u32x4*)(src + 128);
        }
#pragma unroll
        for (int u = 0; u < 5; ++u) {
            float o[8];
#pragma unroll
            for (int j = 0; j < 4; ++j) { o[2 * j] = __uint_as_float(a0[u][j] << 16) - lam * __uint_as_float(a1[u][j] << 16); o[2 * j + 1] = __uint_as_float(a0[u][j] & 0xffff0000u) - lam * __uint_as_float(a1[u][j] & 0xffff0000u); }
            float ss = 0.f;
#pragma unroll
            for (int j = 0; j < 8; ++j) ss += o[j] * o[j];
            ss += dppx<0xB1>(ss); ss += dppx<0x4E>(ss); ss += dppx<0x141>(ss); ss += dppx<0x140>(ss);
            const float rs = rsqrtf(ss * (1.0f / 128.0f) + EPS) * (1.0f - lam_init);
            const u32x4 ov = {pk2(o[0] * rs * ga[0], o[1] * rs * ga[1]), pk2(o[2] * rs * ga[2], o[3] * rs * ga[3]), pk2(o[4] * rs * gb[0], o[5] * rs * gb[1]), pk2(o[6] * rs * gb[2], o[7] * rs * gb[3])};
            const int t = tk[u] >> 2, H = tk[u] & 3;
            if (u < 4 || (extra && w == 0)) __builtin_amdgcn_raw_buffer_store_b128(ov, mrs, (unsigned)((t * D + 1536 + H * 128 + 8 * l16) * 2), 0, 16);
        }
        asm volatile("s_waitcnt vmcnt(0)" ::: "memory");
        __syncthreads();
        if (tidq == 0) { (void)xb_add(pubc + (blk >> 3), 1u); if (extra) (void)xb_add(pubc + MPG8 / 256, 1u); }
    }
}

typedef short s16x4 __attribute__((ext_vector_type(4)));
constexpr int SSM_NSEG = 8, SSM_PITCH = 72;
__device__ __forceinline__ int ssm_tile0(int k) { return (k * 65) >> 3; }
template <bool FULL>
__device__ __forceinline__ void ssm_pass(KP& p, int layer, const bf16_t* qkv, bf16_t* yb, float* S, unsigned char* lds, const f32x4* ssmt) {
    const int tidq = tid_opaque(), lane = tidq & 63, w = tidq >> 6, c31 = lane & 31, hh = lane >> 5;
    if (blockIdx.x >= NBATCH * SSM_G) return;
    const int item = blockIdx.x * NWV + w;
    const int pair = item >> 3, seg = item & 7, b = pair / SSM_G, g = pair % SSM_G, lg = layer * SSM_G + g;
    float a1r[2], a1i[2], a2r[2], a2i[2], a3r[2], a3i[2], a4r[2], a4i[2], a256r[2], a256i[2];
    bf16x8 bfr[4];
#pragma unroll
    for (int pp = 0; pp < 2; ++pp) {
        const int gp = lg * SSM_P + pp * 32 + c31;
        const f32x4 tv = ssmt[gp], tv2 = ssmt[2 * SSM_G * SSM_P + gp], tv4 = ssmt[4 * SSM_G * SSM_P + gp];
        const float fr = tv[2], fi = tv[3];
        a1r[pp] = tv[0]; a1i[pp] = tv[1]; a2r[pp] = tv2[0]; a2i[pp] = tv2[1]; a3r[pp] = tv2[2]; a3i[pp] = tv2[3]; a4r[pp] = tv4[0]; a4i[pp] = tv4[1];
        a256r[pp] = tv4[2]; a256i[pp] = tv4[3];
        const f32x4 br0 = *(const f32x4*)(p.b_re + (size_t)gp * 16 + 8 * hh), br1 = *(const f32x4*)(p.b_re + (size_t)gp * 16 + 8 * hh + 4);
        const f32x4 bi0 = *(const f32x4*)(p.b_im + (size_t)gp * 16 + 8 * hh), bi1 = *(const f32x4*)(p.b_im + (size_t)gp * 16 + 8 * hh + 4);
        u32x4 wr = {pk2(fr * br0[0] - fi * bi0[0], fr * br0[1] - fi * bi0[1]), pk2(fr * br0[2] - fi * bi0[2], fr * br0[3] - fi * bi0[3]),
                    pk2(fr * br1[0] - fi * bi1[0], fr * br1[1] - fi * bi1[1]), pk2(fr * br1[2] - fi * bi1[2], fr * br1[3] - fi * bi1[3])};
        u32x4 wi = {pk2(fr * bi0[0] + fi * br0[0], fr * bi0[1] + fi * br0[1]), pk2(fr * bi0[2] + fi * br0[2], fr * bi0[3] + fi * br0[3]),
                    pk2(fr * bi1[0] + fi * br1[0], fr * bi1[1] + fi * br1[1]), pk2(fr * bi1[2] + fi * br1[2], fr * bi1[3] + fi * br1[3])};
        bfr[pp] = *(bf16x8*)&wr; bfr[2 + pp] = *(bf16x8*)&wi;
    }
    float a16r[2], a16i[2];
#pragma unroll
    for (int pp = 0; pp < 2; ++pp) {
        const float a8r = a4r[pp] * a4r[pp] - a4i[pp] * a4i[pp], a8i = a4r[pp] * a4i[pp] + a4i[pp] * a4r[pp];
        a16r[pp] = a8r * a8r - a8i * a8i; a16i[pp] = a8r * a8i + a8i * a8r;
    }
    unsigned char* ctab = lds + NWV * (128 * SSM_PITCH);
    if (FULL) {
        {
            const int kk = w;
            u32x4 wv = {0u, 0u, 0u, 0u};
            if (c31 < 16) {
                const int pbase = (16 * kk + 8 * hh) & 63;
                const float* cp = ((kk >> 2) ? p.c_im : p.c_re) + ((size_t)lg * 16 + c31) * SSM_P + pbase;
                const float sg = (kk >> 2) ? -1.0f : 1.0f;
                const f32x4 c0 = *(const f32x4*)cp, c1 = *(const f32x4*)(cp + 4);
                wv = (u32x4){pk2(sg * c0[0], sg * c0[1]), pk2(sg * c0[2], sg * c0[3]), pk2(sg * c1[0], sg * c1[1]), pk2(sg * c1[2], sg * c1[3])};
            }
            *(u32x4*)(ctab + (kk * 64 + lane) * 16) = wv;
        }
        if (w == 0) {
            const float dsk = (c31 < 16) ? p.dskip[layer * SSM_W + g * 16 + c31] : 0.f;
            float dv[8];
#pragma unroll
            for (int j = 0; j < 8; ++j) dv[j] = (8 * hh + j == c31) ? dsk : 0.f;
            u32x4 wd = {pk2(dv[0], dv[1]), pk2(dv[2], dv[3]), pk2(dv[4], dv[5]), pk2(dv[6], dv[7])};
            *(u32x4*)(ctab + (8 * 64 + lane) * 16) = wd;
        }
        __syncthreads();
    }
    float cr[2] = {0.f, 0.f}, ci[2] = {0.f, 0.f};
    if (FULL && seg > 0) {
        float pr[2] = {a256r[0], a256r[1]}, pi[2] = {a256i[0], a256i[1]};
        for (int k2 = 0; k2 < seg; ++k2) {
            const float* sp = S + k2 * 128 + c31;
#pragma unroll
            for (int pp = 0; pp < 2; ++pp) {
                const float sr = sp[pp * 32], si = sp[64 + pp * 32];
                const float nr2 = pr[pp] * cr[pp] - pi[pp] * ci[pp] + sr, ni2 = pr[pp] * ci[pp] + pi[pp] * cr[pp] + si;
                cr[pp] = nr2; ci[pp] = ni2;
            }
        }
    }
    unsigned char* img = lds + w * (128 * SSM_PITCH);
    const int t1 = ssm_tile0(seg + 1);
    const int tperm = (c31 & 3) | ((c31 >> 3) << 2) | (((c31 >> 2) & 1) << 4);
    bf16x8 uf_nx, ufn_nx = {0, 0, 0, 0, 0, 0, 0, 0};
    {
        const int t0_ = ssm_tile0(seg), tp = t0_ * 32 + tperm, tq = t0_ * 32 + c31;
        uf_nx = *(const bf16x8*)(qkv + (size_t)(b * LT + (tp < LT ? tp : LT - 1)) * INW + OFF_US + g * 16 + 8 * hh);
        if (FULL) ufn_nx = *(const bf16x8*)(qkv + (size_t)(b * LT + (tq < LT ? tq : LT - 1)) * INW + OFF_US + g * 16 + 8 * hh);
    }
    for (int tile = ssm_tile0(seg); tile < t1; ++tile) {
        const bf16x8 z8 = {0, 0, 0, 0, 0, 0, 0, 0};
        const bf16x8 uf = (tile * 32 + tperm < LT) ? uf_nx : z8;
        const bf16x8 ufn = (FULL && tile * 32 + c31 < LT) ? ufn_nx : z8;
        {
            const int tn = tile + 1 < t1 ? tile + 1 : tile;
            const int tp = tn * 32 + tperm, tq = tn * 32 + c31;
            uf_nx = *(const bf16x8*)(qkv + (size_t)(b * LT + (tp < LT ? tp : LT - 1)) * INW + OFF_US + g * 16 + 8 * hh);
            if (FULL) ufn_nx = *(const bf16x8*)(qkv + (size_t)(b * LT + (tq < LT ? tq : LT - 1)) * INW + OFF_US + g * 16 + 8 * hh);
        }
        f32x16 V[4];
#pragma unroll
        for (int i = 0; i < 4; ++i) {
            f32x16 z;
#pragma unroll
            for (int r = 0; r < 16; ++r) z[r] = 0.f;
            V[i] = __builtin_amdgcn_mfma_f32_32x32x16_bf16(uf, bfr[i], z, 0, 0, 0);
        }
#pragma unroll
        for (int pp = 0; pp < 2; ++pp)
#pragma unroll
            for (int a = 0; a < 4; ++a)
#pragma unroll
                for (int i = 1; i < 4; ++i) {
                    const float xr = V[pp][4 * a + i - 1], xi = V[2 + pp][4 * a + i - 1];
                    V[pp][4 * a + i] += a1r[pp] * xr - a1i[pp] * xi;
                    V[2 + pp][4 * a + i] += a1r[pp] * xi + a1i[pp] * xr;
                }
        float cinr[2][4], cini[2][4];
#pragma unroll
        for (int pp = 0; pp < 2; ++pp) {
            float zr = 0.f, zi = 0.f;
#pragma unroll
            for (int a = 0; a < 4; ++a) {
                cinr[pp][a] = zr; cini[pp][a] = zi;
                const float nr2 = V[pp][4 * a + 3] + a4r[pp] * zr - a4i[pp] * zi, ni2 = V[2 + pp][4 * a + 3] + a4r[pp] * zi + a4i[pp] * zr;
                zr = nr2; zi = ni2;
            }
            const float lor = xchg32(zr), loi = xchg32(zi);
            const float tr = a16r[pp] * cr[pp] - a16i[pp] * ci[pp] + lor, ti = a16r[pp] * ci[pp] + a16i[pp] * cr[pp] + loi;
            const float kr = hh ? tr : cr[pp], ki = hh ? ti : ci[pp];
            if (FULL) {
                const float w1r = a4r[pp] * kr - a4i[pp] * ki, w1i = a4r[pp] * ki + a4i[pp] * kr;
                const float w2r = a4r[pp] * w1r - a4i[pp] * w1i, w2i = a4r[pp] * w1i + a4i[pp] * w1r;
                const float w3r = a4r[pp] * w2r - a4i[pp] * w2i, w3i = a4r[pp] * w2i + a4i[pp] * w2r;
                cinr[pp][1] += w1r; cini[pp][1] += w1i; cinr[pp][2] += w2r; cini[pp][2] += w2i; cinr[pp][3] += w3r; cini[pp][3] += w3i;
                cinr[pp][0] = kr; cini[pp][0] = ki;
            }
            const float er = a16r[pp] * kr - a16i[pp] * ki + zr, ei = a16r[pp] * ki + a16i[pp] * kr + zi;
            const float our = xchg32(er), oui = xchg32(ei);
            cr[pp] = hh ? er : our; ci[pp] = hh ? ei : oui;
        }
        if (FULL) {
#pragma unroll
            for (int pp = 0; pp < 2; ++pp)
#pragma unroll
                for (int a = 0; a < 4; ++a) {
                    const float kr = cinr[pp][a], ki = cini[pp][a];
                    V[pp][4 * a + 0] += a1r[pp] * kr - a1i[pp] * ki; V[2 + pp][4 * a + 0] += a1r[pp] * ki + a1i[pp] * kr;
                    V[pp][4 * a + 1] += a2r[pp] * kr - a2i[pp] * ki; V[2 + pp][4 * a + 1] += a2r[pp] * ki + a2i[pp] * kr;
                    V[pp][4 * a + 2] += a3r[pp] * kr - a3i[pp] * ki; V[2 + pp][4 * a + 2] += a3r[pp] * ki + a3i[pp] * kr;
                    V[pp][4 * a + 3] += a4r[pp] * kr - a4i[pp] * ki; V[2 + pp][4 * a + 3] += a4r[pp] * ki + a4i[pp] * kr;
                }
#pragma unroll
            for (int i = 0; i < 4; ++i)
#pragma unroll
                for (int a = 0; a < 4; ++a)
                    *(u32x2*)(img + (i * 32 + c31) * SSM_PITCH + (16 * hh + 4 * a) * 2) = (u32x2){pk2(V[i][4 * a], V[i][4 * a + 1]), pk2(V[i][4 * a + 2], V[i][4 * a + 3])};
            f32x16 y;
#pragma unroll
            for (int r = 0; r < 16; ++r) y[r] = 0.f;
            const int li15 = lane & 15, gsel = (lane >> 4) & 1;
#pragma unroll
            for (int kk = 0; kk < 8; ++kk) {
                const unsigned char* rp = img + (16 * kk + 8 * hh + (li15 >> 2)) * SSM_PITCH + (16 * gsel + 4 * (li15 & 3)) * 2;
                const s16x4 lo = __builtin_amdgcn_ds_read_tr16_b64_v4i16((__attribute__((address_space(3))) s16x4*)(rp));
                const s16x4 hi = __builtin_amdgcn_ds_read_tr16_b64_v4i16((__attribute__((address_space(3))) s16x4*)(rp + 4 * SSM_PITCH));
                const bf16x8 af = {lo[0], lo[1], lo[2], lo[3], hi[0], hi[1], hi[2], hi[3]};
                y = __builtin_amdgcn_mfma_f32_32x32x16_bf16(af, *(const bf16x8*)(ctab + (kk * 64 + lane) * 16), y, 0, 0, 0);
            }
            y = __builtin_amdgcn_mfma_f32_32x32x16_bf16(ufn, *(const bf16x8*)(ctab + (8 * 64 + lane) * 16), y, 0, 0, 0);
            {
                const int cc = c31 & 15, rsel = c31 >> 4;
#pragma unroll
                for (int r = 0; r < 8; ++r) {
                    const auto sw = __builtin_amdgcn_permlane16_swap(__float_as_uint(y[r]), __float_as_uint(y[r + 8]), false, false);
                    const float v = __uint_as_float(sw[0]);
                    const int rr = r + 8 * rsel;
                    const int tk = tile * 32 + (rr & 3) + 8 * (rr >> 2) + 4 * hh;
                    if (tk < LT) {
                        const float z2 = 1.5957691216057308f * (v + 0.044715f * v * v * v);
                        yb[(size_t)(b * LT + tk) * SSM_W + g * 16 + cc] = f2bf(v * __builtin_amdgcn_rcpf(1.0f + __expf(-z2)));
                    }
                }
            }
        }
    }
    if (!FULL && hh == 0) {
        float* sp = S + seg * 128 + c31;
        sp[0] = cr[0]; sp[32] = cr[1]; sp[64] = ci[0]; sp[96] = ci[1];
    }
}

template <int MODE>
__device__ __forceinline__ void phase_gemm_dense(unsigned char* lds, const bf16_t* A, int K, const float* B, int N, float* h, bf16_t* outb, const bf16_t* yb, int tm_lo, int ksplit, const bf16_t* zrow, unsigned* pubc = nullptr, unsigned* waitc = nullptr, unsigned* bar = nullptr) {
    const int npair = N / 256, ntm = (NTOK + BM - 1) / BM - tm_lo, Ksub = K / ksplit;
    const int tid = tid_opaque(), lane = tid & 63, th = tid & 255, wave = (tid >> 6) & 3, wm = wave >> 1, wn = wave & 1, c31 = lane & 31, hh = lane >> 5;
    const int hsel = __builtin_amdgcn_readfirstlane(tid >> 8);
    f32x4 rbs[2][8];
    bool bpre = false;
    const __amdgpu_buffer_rsrc_t prs = __builtin_amdgcn_make_buffer_rsrc((void*)h, 0, 16 * (NTOK - MPG8) * D * 4, 0x00020000);
    int task0 = (int)blockIdx.x;
    if (MODE == 3) { task0 -= (int)gridDim.x - npair * ntm * ksplit; if (task0 < 0) task0 += (int)gridDim.x; }
    if (MODE == 3 && task0 < npair * ntm * ksplit) {
        if (tid == 0) { XB_SPIN(xb_ld(waitc) < 67u, bar); __builtin_amdgcn_fence(__ATOMIC_ACQUIRE, "agent"); asm volatile("s_waitcnt vmcnt(0)" ::: "memory"); }
        __syncthreads();
    }
    for (int task = task0; task < npair * ntm * ksplit; task += gridDim.x) {
        const int ks = task % ksplit, tile = task / ksplit;
        int tm = tm_lo + tile % ntm; const int tn = 2 * (tile / ntm) + hsel;
        asm volatile("" : "+s"(tm));
        const int rb_ = tm * BM + 64 * hsel + (th >> 3);
        const bf16_t* ap0 = rb_ < NTOK ? A + (size_t)rb_ * K + ks * Ksub : zrow;
        const bf16_t* ap1 = rb_ + 32 < NTOK ? A + (size_t)(rb_ + 32) * K + ks * Ksub : zrow;
        const float* bp = B + (size_t)ks * Ksub * N + tn * 128 + 4 * (th & 31);
        const int task2 = task + gridDim.x; const bool has_next = task2 < npair * ntm * ksplit;
        const float* bnext = has_next ? B + (size_t)(task2 % ksplit) * Ksub * N + (2 * ((task2 / ksplit) / ntm) + hsel) * 128 + 4 * (th & 31) : bp;
        f32x16 acc[2][2];
        gemm_dual(lds, ap0, ap1, bp, N, Ksub, acc, rbs, bpre, bnext);
        bpre = has_next;
        const int cb = tn * 128 + wn * 64;
        if (MODE == 3) {
#pragma unroll
            for (int mi = 0; mi < 2; ++mi)
#pragma unroll
                for (int a4 = 0; a4 < 4; ++a4) {
                    const int t = tm * BM + wm * 64 + mi * 32 + 8 * a4 + 4 * hh + (lane & 3);
#pragma unroll
                    for (int ni = 0; ni < 2; ++ni) {
                        float v0 = acc[mi][ni][4 * a4], v1 = acc[mi][ni][4 * a4 + 1], v2 = acc[mi][ni][4 * a4 + 2], v3 = acc[mi][ni][4 * a4 + 3];
                        quad_transpose(v0, v1, v2, v3, lane);
                        if (t < NTOK) { const f32x4 o = {v0, v1, v2, v3}; __builtin_amdgcn_raw_buffer_store_b128(*(const u32x4*)&o, prs, (unsigned)((((ks * (NTOK - MPG8) + (t - MPG8)) * D) + cb + ni * 32 + (c31 & ~3)) * 4), 0, 16); }
                    }
                }
            asm volatile("s_waitcnt vmcnt(0)" ::: "memory");
            __syncthreads();
            if (tid == 0) (void)xb_add(pubc, 1u);
        } else {
            u32x2 y8[2][4][2];
#pragma unroll
            for (int mi = 0; mi < 2; ++mi)
#pragma unroll
                for (int a4 = 0; a4 < 4; ++a4) {
                    const int t = tm * BM + wm * 64 + mi * 32 + 8 * a4 + 4 * hh + (lane & 3);
#pragma unroll
                    for (int ni = 0; ni < 2; ++ni) y8[mi][a4][ni] = t < NTOK ? *(const u32x2*)(yb + (size_t)t * SSM_W + cb + ni * 32 + (c31 & ~3)) : (u32x2){0u, 0u};
                }
            const __amdgpu_buffer_rsrc_t mrs = __builtin_amdgcn_make_buffer_rsrc((void*)outb, 0, NTOK * D * 2, 0x00020000);
            const bool odd = (lane & 4) != 0;
#pragma unroll
            for (int mi = 0; mi < 2; ++mi)
#pragma unroll
                for (int ni = 0; ni < 2; ++ni)
#pragma unroll
                    for (int k2 = 0; k2 < 2; ++k2) {
                        u32x2 d[2];
#pragma unroll
                        for (int s = 0; s < 2; ++s) {
                            const int a4 = 2 * k2 + s;
                            float v0 = acc[mi][ni][4 * a4], v1 = acc[mi][ni][4 * a4 + 1], v2 = acc[mi][ni][4 * a4 + 2], v3 = acc[mi][ni][4 * a4 + 3];
                            quad_transpose(v0, v1, v2, v3, lane);
                            const u32x2 yv = y8[mi][a4][ni];
                            const float y0 = __uint_as_float(yv[0] << 16), y1 = __uint_as_float(yv[0] & 0xffff0000u), y2 = __uint_as_float(yv[1] << 16), y3 = __uint_as_float(yv[1] & 0xffff0000u);
                            d[s] = (u32x2){pk2(y0 * __builtin_amdgcn_rcpf(1.0f + __expf(-v0)), y1 * __builtin_amdgcn_rcpf(1.0f + __expf(-v1))),
                                           pk2(y2 * __builtin_amdgcn_rcpf(1.0f + __expf(-v2)), y3 * __builtin_amdgcn_rcpf(1.0f + __expf(-v3)))};
                        }
                        const unsigned s0 = odd ? d[0][0] : d[1][0], s1 = odd ? d[0][1] : d[1][1];
                        const unsigned r0 = (unsigned)__builtin_amdgcn_ds_swizzle((int)s0, 0x101F), r1 = (unsigned)__builtin_amdgcn_ds_swizzle((int)s1, 0x101F);
                        const unsigned k0 = odd ? d[1][0] : d[0][0], k1 = odd ? d[1][1] : d[0][1];
                        const u32x4 o = odd ? (u32x4){r0, r1, k0, k1} : (u32x4){k0, k1, r0, r1};
                        const int t = tm * BM + wm * 64 + mi * 32 + 8 * (2 * k2 + (odd ? 1 : 0)) + 4 * hh + (lane & 3);
                        if (t < NTOK) __builtin_amdgcn_raw_buffer_store_b128(o, mrs, (unsigned)((t * D + 768 + cb + ni * 32 + (c31 & ~7)) * 2), 0, 16);
                    }
            asm volatile("s_waitcnt vmcnt(0)" ::: "memory");
            __syncthreads();
            if (tid == 0) (void)xb_add(pubc + (tm < MPG8 / BM ? (tm >> 1) : MPG8 / 256), 1u);
        }
    }
}

__device__ __forceinline__ void phase_router(KP& p, int layer, float* h, bf16_t* xn, float* selw, int* lists, int* cnt, const bf16_t* rtab, unsigned char* lds, const float* part_, unsigned* rtc, unsigned* loc, unsigned* bar) {
    const int tid = tid_opaque(), lane = tid & 63, w = tid >> 6, r31 = lane & 31, hh = lane >> 5;
    const bf16_t* thi = rtab + (size_t)(layer * 2 + 0) * 36 * D; const bf16_t* tlo = rtab + (size_t)(layer * 2 + 1) * 36 * D;
    const float* g = p.ffn_g + (size_t)layer * D;
    float* part = (float*)lds;
    float* rsb = (float*)(lds + 8 * 21 * 64 * 4);
    for (int item = blockIdx.x; item < MPG8 / 32; item += gridDim.x) {
        if (tid == 0) { XB_SPIN(xb_ld(&rtc[item >> 3]) < (unsigned)(D / 256), bar); __builtin_amdgcn_fence(__ATOMIC_ACQUIRE, "agent"); asm volatile("s_waitcnt vmcnt(0)" ::: "memory"); }
        __syncthreads();
        const int t = item * 32 + r31;
        const float* hrow = h + (size_t)t * D + w * 256 + 8 * hh;
        f32x16 a0, a1;
#pragma unroll
        for (int r = 0; r < 16; ++r) { a0[r] = 0.f; a1[r] = 0.f; }
        float ss = 0.f;
#pragma unroll 4
        for (int ks = 0; ks < 16; ++ks) {
            const f32x4 x0 = *(const f32x4*)(hrow + ks * 16), x1 = *(const f32x4*)(hrow + ks * 16 + 4);
            ss += x0[0] * x0[0] + x0[1] * x0[1] + x0[2] * x0[2] + x0[3] * x0[3] + x1[0] * x1[0] + x1[1] * x1[1] + x1[2] * x1[2] + x1[3] * x1[3];
            u32x4 bh = {pk2(x0[0], x0[1]), pk2(x0[2], x0[3]), pk2(x1[0], x1[1]), pk2(x1[2], x1[3])};
            u32x4 bl = {pk2(x0[0] - __uint_as_float(bh[0] << 16), x0[1] - __uint_as_float(bh[0] & 0xffff0000u)), pk2(x0[2] - __uint_as_float(bh[1] << 16), x0[3] - __uint_as_float(bh[1] & 0xffff0000u)),
                        pk2(x1[0] - __uint_as_float(bh[2] << 16), x1[1] - __uint_as_float(bh[2] & 0xffff0000u)), pk2(x1[2] - __uint_as_float(bh[3] << 16), x1[3] - __uint_as_float(bh[3] & 0xffff0000u))};
            const bf16x8 hhi = *(bf16x8*)&bh, hlo = *(bf16x8*)&bl;
            const size_t ko = (size_t)w * 256 + ks * 16 + 8 * hh;
            const size_t kf = ((size_t)(w * 16 + ks) * 64 + lane) * 8;
            const bf16x8 w0h = *(const bf16x8*)(thi + kf), w0l = *(const bf16x8*)(tlo + kf);
            bf16x8 w1h = {0, 0, 0, 0, 0, 0, 0, 0}, w1l = {0, 0, 0, 0, 0, 0, 0, 0};
            if (r31 < 4) { w1h = *(const bf16x8*)(thi + (size_t)(32 + r31) * D + ko); w1l = *(const bf16x8*)(tlo + (size_t)(32 + r31) * D + ko); }
            a0 = __builtin_amdgcn_mfma_f32_32x32x16_bf16(w0h, hhi, a0, 0, 0, 0);
            a0 = __builtin_amdgcn_mfma_f32_32x32x16_bf16(w0h, hlo, a0, 0, 0, 0);
            a0 = __builtin_amdgcn_mfma_f32_32x32x16_bf16(w0l, hhi, a0, 0, 0, 0);
            a1 = __builtin_amdgcn_mfma_f32_32x32x16_bf16(w1h, hhi, a1, 0, 0, 0);
            a1 = __builtin_amdgcn_mfma_f32_32x32x16_bf16(w1h, hlo, a1, 0, 0, 0);
            a1 = __builtin_amdgcn_mfma_f32_32x32x16_bf16(w1l, hhi, a1, 0, 0, 0);
        }
#pragma unroll
        for (int r = 0; r < 16; ++r) part[(w * 21 + r) * 64 + lane] = a0[r];
#pragma unroll
        for (int r = 0; r < 4; ++r) part[(w * 21 + 16 + r) * 64 + lane] = a1[r];
        part[(w * 21 + 20) * 64 + lane] = ss;
        __syncthreads();
        int re1 = 0, re2 = 0, rp1 = 0, rp2 = 0; float rw1 = 0.f, rw2 = 0.f;
        if (w == 0) {
            float el[16], gl[4], st = 0.f;
#pragma unroll
            for (int r = 0; r < 16; ++r) { float s = 0.f;
#pragma unroll
                for (int q = 0; q < 8; ++q) s += part[(q * 21 + r) * 64 + lane]; el[r] = s; }
#pragma unroll
            for (int r = 0; r < 4; ++r) { float s = 0.f;
#pragma unroll
                for (int q = 0; q < 8; ++q) s += part[(q * 21 + 16 + r) * 64 + lane]; gl[r] = s; }
#pragma unroll
            for (int q = 0; q < 8; ++q) st += part[(q * 21 + 20) * 64 + lane];
            st += xchg32(st);
            const float rs = rsqrtf(st * (1.0f / D) + EPS);
            if (hh == 0) rsb[r31] = rs;
#pragma unroll
            for (int c = 0; c < 4; ++c) { const float o = xchg32(gl[c]); gl[c] = (hh == 0 ? gl[c] : o) * rs + p.rg_b[layer * 4 + c]; }
            int gs = 0; float gm = gl[0];
#pragma unroll
            for (int c = 1; c < 4; ++c) if (gl[c] > gm) { gm = gl[c]; gs = c; }
            float gsum = 0.f;
#pragma unroll
            for (int c = 0; c < 4; ++c) gsum += expf(gl[c] - gm);
            const float pg = 1.0f / gsum;
            float e4[4];
#pragma unroll
            for (int i = 0; i < 4; ++i) { float v = el[i];
#pragma unroll
                for (int gi = 1; gi < 4; ++gi) v = (gs == gi) ? el[4 * gi + i] : v;
                float bb = p.re_b[layer * 32 + 4 * hh + i];
#pragma unroll
                for (int gi = 1; gi < 4; ++gi) bb = (gs == gi) ? p.re_b[layer * 32 + gi * 8 + 4 * hh + i] : bb;
                e4[i] = v * rs + bb; }
            int i1 = 0; float b1 = e4[0];
#pragma unroll
            for (int i = 1; i < 4; ++i) if (e4[i] > b1) { b1 = e4[i]; i1 = i; }
            int i2 = -1; float b2 = -3.0e38f;
#pragma unroll
            for (int i = 0; i < 4; ++i) if (i != i1 && e4[i] > b2) { b2 = e4[i]; i2 = i; }
            i1 += 4 * hh; i2 += 4 * hh;
            const float ob1 = xchg32(b1), ob2 = xchg32(b2); const int oi1 = xchg32i(i1), oi2 = xchg32i(i2);
            float f1, f2; int j1, j2;
            const bool mine_first = (b1 > ob1) || (b1 == ob1 && i1 < oi1);
            if (mine_first) { f1 = b1; j1 = i1; const bool s = (b2 > ob1) || (b2 == ob1 && i2 < oi1); f2 = s ? b2 : ob1; j2 = s ? i2 : oi1; }
            else { f1 = ob1; j1 = oi1; const bool s = (ob2 > b1) || (ob2 == b1 && oi2 < i1); f2 = s ? ob2 : b1; j2 = s ? oi2 : i1; }
            const float x2 = expf(f2 - f1);
            const float w1 = pg / (1.0f + x2), w2 = pg * x2 / (1.0f + x2);
            if (hh == 0) {
                re1 = gs * 8 + j1; re2 = gs * 8 + j2; rw1 = w1; rw2 = w2;
                rp1 = atomicAdd(&cnt[re1], 1);
                rp2 = atomicAdd(&cnt[re2], 1);
            }
        }
        asm volatile("s_waitcnt lgkmcnt(0)" ::: "memory");
        __builtin_amdgcn_s_barrier();
        {
            const float rs = rsb[r31];
            bf16_t* xrow = xn + (size_t)t * D + w * 256 + 8 * hh;
            const float* gk = g + w * 256 + 8 * hh;
            for (int kb = 0; kb < 16; kb += 8) {
                f32x4 x0[8], x1[8], g0[8], g1[8];
#pragma unroll
                for (int u = 0; u < 8; ++u) { const int ks = kb + u; x0[u] = *(const f32x4*)(hrow + ks * 16); x1[u] = *(const f32x4*)(hrow + ks * 16 + 4); g0[u] = *(const f32x4*)(gk + ks * 16); g1[u] = *(const f32x4*)(gk + ks * 16 + 4); }
#pragma unroll
                for (int u = 0; u < 8; ++u) { const int ks = kb + u;
                    *(u32x4*)(xrow + ks * 16) = (u32x4){pk2(x0[u][0] * rs * g0[u][0], x0[u][1] * rs * g0[u][1]), pk2(x0[u][2] * rs * g0[u][2], x0[u][3] * rs * g0[u][3]), pk2(x1[u][0] * rs * g1[u][0], x1[u][1] * rs * g1[u][1]), pk2(x1[u][2] * rs * g1[u][2], x1[u][3] * rs * g1[u][3])}; }
            }
        }
        if (w == 0 && hh == 0) {
            lists[(size_t)re1 * NTOK + rp1] = 2 * t; selw[2 * t] = rw1;
            lists[(size_t)re2 * NTOK + rp2] = 2 * t + 1; selw[2 * t + 1] = rw2;
        }
        __syncthreads();
    }
    {
        float* red = (float*)(lds + 49152);
        float* fin = red + 8 * 40;
        for (int te = MPG8 + blockIdx.x; te < NTOK; te += gridDim.x) {
            if (tid == 0) { XB_SPIN(xb_ld(loc) < 128u, bar); __builtin_amdgcn_fence(__ATOMIC_ACQUIRE, "agent"); asm volatile("s_waitcnt vmcnt(0)" ::: "memory"); }
            __syncthreads();
            const int k0 = 4 * tid;
            float* hr = h + (size_t)te * D + k0;
            f32x4 x = *(const f32x4*)hr;
            {
                const float* pp = part_ + (size_t)(te - MPG8) * D + k0;
                f32x4 pv[16];
#pragma unroll
                for (int ks = 0; ks < 16; ++ks) pv[ks] = *(const f32x4*)(pp + (size_t)ks * (NTOK - MPG8) * D);
#pragma unroll
                for (int ks = 0; ks < 16; ++ks) x += pv[ks];
            }
            const f32x4 gv = *(const f32x4*)(g + k0);
            const float bias = tid < 32 ? p.re_b[layer * 32 + tid] : (tid < 36 ? p.rg_b[layer * 4 + tid - 32] : 0.f);
            float al[36];
#pragma unroll
            for (int c = 0; c < 36; ++c) al[c] = 0.f;
#pragma unroll
            for (int kk = 0; kk < 4; ++kk) {
                const float xg = x[kk] * gv[kk];
                const float* wr = p.re_w + ((size_t)layer * D + k0 + kk) * 32;
#pragma unroll
                for (int c4 = 0; c4 < 8; ++c4) { const f32x4 wv = *(const f32x4*)(wr + 4 * c4); al[4 * c4] += xg * wv[0]; al[4 * c4 + 1] += xg * wv[1]; al[4 * c4 + 2] += xg * wv[2]; al[4 * c4 + 3] += xg * wv[3]; }
                const f32x4 wg = *(const f32x4*)(p.rg_w + ((size_t)layer * D + k0 + kk) * 4);
                al[32] += xg * wg[0]; al[33] += xg * wg[1]; al[34] += xg * wg[2]; al[35] += xg * wg[3];
            }
            float ss = wave_sum(x[0] * x[0] + x[1] * x[1] + x[2] * x[2] + x[3] * x[3]);
#pragma unroll
            for (int c = 0; c < 36; ++c) al[c] = wave_sum(al[c]);
            if (lane == 0) {
#pragma unroll
                for (int c = 0; c < 36; ++c) red[w * 40 + c] = al[c];
                red[w * 40 + 36] = ss;
            }
            __syncthreads();
            float rs;
            {
                float s = 0.f, s2 = 0.f;
#pragma unroll
                for (int q = 0; q < 8; ++q) { s += red[q * 40 + (tid < 36 ? tid : 36)]; s2 += red[q * 40 + 36]; }
                rs = rsqrtf(s2 * (1.0f / D) + EPS);
                if (tid < 36) fin[tid] = s * rs + bias;
            }
            __syncthreads();
            if (tid == 0) {
                float gl[4];
#pragma unroll
                for (int c = 0; c < 4; ++c) gl[c] = fin[32 + c];
                int gs = 0; float gm = gl[0];
#pragma unroll
                for (int c = 1; c < 4; ++c) if (gl[c] > gm) { gm = gl[c]; gs = c; }
                float gsum = 0.f;
#pragma unroll
                for (int c = 0; c < 4; ++c) gsum += expf(gl[c] - gm);
                const float pg = 1.0f / gsum;
                float f1 = -3.0e38f, f2 = -3.0e38f; int j1 = 0, j2 = 0;
                for (int i = 0; i < 8; ++i) {
                    const float v = fin[gs * 8 + i];
                    if (v > f1) { f2 = f1; j2 = j1; f1 = v; j1 = i; } else if (v > f2) { f2 = v; j2 = i; }
                }
                const float x2 = expf(f2 - f1);
                const float w1 = pg / (1.0f + x2), w2 = pg * x2 / (1.0f + x2);
                const int e1 = gs * 8 + j1, e2 = gs * 8 + j2;
                const int p1 = atomicAdd(&cnt[e1], 1); lists[(size_t)e1 * NTOK + p1] = 2 * te; selw[2 * te] = w1;
                const int p2 = atomicAdd(&cnt[e2], 1); lists[(size_t)e2 * NTOK + p2] = 2 * te + 1; selw[2 * te + 1] = w2;
            }
            *(f32x4*)hr = x;
            *(u32x2*)(xn + (size_t)te * D + k0) = (u32x2){pk2(x[0] * rs * gv[0], x[1] * rs * gv[1]), pk2(x[2] * rs * gv[2], x[3] * rs * gv[3])};
            __syncthreads();
        }
    }
}

__device__ __forceinline__ void moe_decode(int lt, const int (&ex4)[4], const int (&ntm4)[4], int ntq, int& e, int& j, int& tq) {
    int r = lt, ntm = ntm4[0], q = 0; e = ex4[0];
#pragma unroll
    for (int k = 1; k < 4; ++k) { const int span = ntm4[k - 1] * ntq; if (q == k - 1 && r >= span) { r -= span; q = k; e = ex4[k]; ntm = ntm4[k]; } }
    ntm = ntm > 0 ? ntm : 1;
    j = r % ntm; tq = r / ntm;
}
__device__ __forceinline__ void moe_decode2(int lt, int totU, const int (&ex4)[4], const int (&ntm4)[4], bool& up, int& e, int& j, int& tq) {
    up = lt < totU;
    moe_decode(up ? lt : lt - totU, ex4, ntm4, up ? DEXP / 128 : D / 256, e, j, tq);
}
__device__ __forceinline__ int moe_qtiles(const int* order, int x) { return (order[x] >> 8) + (order[15 - x] >> 8) + (order[16 + x] >> 8) + (order[31 - x] >> 8); }
__device__ __forceinline__ int moe_decode_t0(unsigned tkx, const int* order) {
    const int xs = (int)(tkx >> 28), t = (int)(tkx & 0x0fffffffu);
    const int o0 = order[xs], o1 = order[15 - xs], o2 = order[16 + xs], o3 = order[31 - xs];
    const int n0 = o0 >> 8, n1 = o1 >> 8, n2 = o2 >> 8, sum = n0 + n1 + n2 + (o3 >> 8);
    const int totU = sum * (DEXP / 128), tot = totU + sum * (D / 256);
    if (t >= tot) return -2;
    const int up = t < totU ? 1 : 0, ntq = up ? DEXP / 128 : D / 256;
    int r = up ? t : t - totU, o = o0;
    if (r >= n0 * ntq) { r -= n0 * ntq; o = o1; if (r >= n1 * ntq) { r -= n1 * ntq; o = o2; if (r >= n2 * ntq) { r -= n2 * ntq; o = o3; } } }
    int ntm = o >> 8; ntm = ntm > 0 ? ntm : 1;
    return (up << 20) | ((o & 255) << 12) | ((r % ntm) << 4) | (r / ntm);
}
__device__ __forceinline__ unsigned moe_reserve(int xs, unsigned* dep) { return ((unsigned)xs << 28) | ((unsigned)(((int)gridDim.x - xs + 7) >> 3) + xb_add(dep + 32 * xs, 1u)); }
__device__ __forceinline__ int moe_steal(unsigned& tkx, const int* order, unsigned* dep) {
    for (int guard = 0; guard < 64; ++guard) {
        unsigned tv[8];
#pragma unroll
        for (int s = 0; s < 8; ++s) tv[s] = xb_ld(dep + 32 * s);
        int best = -1, bv = 0;
#pragma unroll
        for (int s = 0; s < 8; ++s) {
            const int rem = moe_qtiles(order, s) * (DEXP / 128 + D / 256) - ((((int)gridDim.x - s + 7) >> 3) + (int)tv[s]);
            if (rem > bv) { bv = rem; best = s; }
        }
        if (best < 0) return -1;
        tkx = moe_reserve(best, dep);
        const int d = moe_decode_t0(tkx, order);
        if (d >= 0) return d;
    }
    return -1;
}

__device__ __forceinline__ void phase_moe2(KP& p, int layer, unsigned char* lds, const bf16_t* xn, bf16_t* G, bf16_t* Y, const float* selw, const int* lists, const int* cnt, const bf16_t* zrow, unsigned* dep, unsigned* bar) {
    int* rowa = (int*)(lds + LDS_ROWA);
    float* roww = (float*)(lds + LDS_SX);
    const int tid = tid_opaque(), lane = tid & 63, wave = (tid >> 6) & 3, wm = wave >> 1, wn = wave & 1, c31 = lane & 31, hh = lane >> 5;
    const int hsel = __builtin_amdgcn_readfirstlane(tid >> 8);
    const int xg = blockIdx.x & 7, jg = blockIdx.x >> 3;
    int* order = (int*)(lds + LDS_PRE);
    volatile int* misc = (volatile int*)(lds + LDS_PRE + 192);
    if (tid < NEXP) {
        const int ce = cnt[tid]; int rank = 0;
        for (int e2 = 0; e2 < NEXP; ++e2) { const int c2 = cnt[e2]; rank += (c2 > ce || (c2 == ce && e2 < tid)) ? 1 : 0; }
        order[rank] = tid | (((ce + BM - 1) / BM) << 8);
    }
    unsigned* rdy = dep + DEP_RDY;
    f32x4 rbs[2][8];
    bool bpre = false;
    int nx_a = -1;
    unsigned tkx = ((unsigned)xg << 28) | (unsigned)jg, rdv = 0u; bool acq = false;
    bool pup = false; int pslot = 0;
    int cdesc = -2;
#define MOE_ACQUIRE()                                                                              \
    {                                                                                              \
        __syncthreads();                                                                           \
        if (tid == 0) {                                                                            \
            int d = moe_decode_t0(tkx, order);                                                     \
            if (d < 0) d = moe_steal(tkx, order, dep);                                             \
            misc[0] = d;                                                                           \
            if (d >= 0) tkx = moe_reserve((int)(tkx >> 28), dep);                                  \
        }                                                                                          \
        __syncthreads();                                                                           \
        cdesc = __builtin_amdgcn_readfirstlane(misc[0]);                                           \
        bpre = false; nx_a = -1; rdv = 0u; acq = false;                                            \
        if (cdesc >= 0 && tid < BM) { const int e0 = (cdesc >> 12) & 31, j0 = (cdesc >> 4) & 127; const int idx = j0 * BM + tid; nx_a = idx < cnt[e0] ? lists[(size_t)e0 * NTOK + idx] : -1; } \
    }
    MOE_ACQUIRE();
    while (cdesc >= 0) {
        const bool up = (cdesc >> 20) != 0; const int e = (cdesc >> 12) & 31, j = (cdesc >> 4) & 127, tq = cdesc & 15;
        const int tn = 2 * tq + hsel;
        if (pup) asm volatile("s_waitcnt vmcnt(0)" ::: "memory");
        __syncthreads();
        if (tid < BM) rowa[tid] = nx_a;
        float wsel = 0.f;
        if (!up && tid < BM && nx_a >= 0) wsel = selw[nx_a];
        if (tid == 0) {
            if (pup) (void)xb_add(&rdy[pslot], 1u);
            misc[0] = moe_decode_t0(tkx, order);
            if (!up) {
                if (!acq) { XB_SPIN(xb_ld(&rdy[e * 72 + j]) < 4u, bar); __builtin_amdgcn_fence(__ATOMIC_ACQUIRE, "agent"); }
                asm volatile("s_waitcnt vmcnt(0)" ::: "memory");
            }
        }
        __syncthreads();
        const int ndesc = __builtin_amdgcn_readfirstlane(misc[0]);
        const bool has_next = ndesc >= 0;
        bool up2 = up; int e2 = e, j2 = j, tq2 = tq;
        if (has_next) { up2 = (ndesc >> 20) != 0; e2 = (ndesc >> 12) & 31; j2 = (ndesc >> 4) & 127; tq2 = ndesc & 15; }
        const int tn2 = 2 * tq2 + hsel;
        if (has_next && tid < BM) { const int idx = j2 * BM + tid; nx_a = idx < cnt[e2] ? lists[(size_t)e2 * NTOK + idx] : -1; }
        if (tid == 0 && has_next && !up2) rdv = xb_ld(&rdy[e2 * 72 + j2]);
        const int th = tid_opaque() & 255;
        const int a0 = rowa[64 * hsel + (th >> 3)], a1 = rowa[64 * hsel + (th >> 3) + 32];
        const size_t eo = (size_t)(layer * NEXP + e), eo2 = (size_t)(layer * NEXP + e2);
        const float* bnext;
        { const int nl = 4 * (th & 31), bwn = nl >> 6, half = (nl >> 5) & 1, c = nl & 31;
          bnext = up2 ? (half ? p.wu : p.wg) + eo2 * D * DEXP + tn2 * 64 + bwn * 32 + c : p.wd + eo2 * DEXP * D + tn2 * 128 + 4 * (th & 31); }
        f32x16 acc[2][2];
        {
            const bf16_t* abase = up ? xn : G; const int ash = up ? 1 : 0, ald = up ? D : DEXP;
            const bf16_t* ap0 = a0 >= 0 ? abase + (size_t)(a0 >> ash) * ald : zrow; const bf16_t* ap1 = a1 >= 0 ? abase + (size_t)(a1 >> ash) * ald : zrow;
            const int nl = 4 * (th & 31), bwn = nl >> 6, half = (nl >> 5) & 1, c = nl & 31;
            const float* bp = up ? (half ? p.wu : p.wg) + eo * D * DEXP + tn * 64 + bwn * 32 + c : p.wd + eo * DEXP * D + tn * 128 + nl;
            gemm_dual(lds, ap0, ap1, bp, up ? DEXP : D, up ? D : DEXP, acc, rbs, bpre, bnext, up2 ? DEXP : D);
        }
        if (!up) { if (tid < BM) roww[tid] = wsel; __syncthreads(); }
        if (tid == 0) {
            acq = false;
            if (has_next && !up2 && rdv >= 4u) { __builtin_amdgcn_fence(__ATOMIC_ACQUIRE, "agent"); acq = true; }
            if (has_next) tkx = moe_reserve((int)(tkx >> 28), dep);
        }
        if (up) {
            const __amdgpu_buffer_rsrc_t grs = __builtin_amdgcn_make_buffer_rsrc((void*)G, 0, NASG * DEXP * 2, 0x00020000);
            const bool odd = (lane & 4) != 0;
#pragma unroll
            for (int mi = 0; mi < 2; ++mi)
#pragma unroll
                for (int k2 = 0; k2 < 2; ++k2) {
                    unsigned d[2][2];
#pragma unroll
                    for (int s = 0; s < 2; ++s) {
                        const int a4 = 2 * k2 + s; float v[4];
#pragma unroll
                        for (int i = 0; i < 4; ++i) { const float gv = acc[mi][0][4 * a4 + i], uv = acc[mi][1][4 * a4 + i]; v[i] = gv * __builtin_amdgcn_rcpf(1.0f + __expf(-gv)) * uv; }
                        quad_transpose(v[0], v[1], v[2], v[3], lane);
                        d[s][0] = pk2(v[0], v[1]); d[s][1] = pk2(v[2], v[3]);
                    }
                    const unsigned s0 = odd ? d[0][0] : d[1][0], s1 = odd ? d[0][1] : d[1][1];
                    const unsigned r0 = (unsigned)__builtin_amdgcn_ds_swizzle((int)s0, 0x101F), r1 = (unsigned)__builtin_amdgcn_ds_swizzle((int)s1, 0x101F);
                    const unsigned k0 = odd ? d[1][0] : d[0][0], k1 = odd ? d[1][1] : d[0][1];
                    const u32x4 o = odd ? (u32x4){r0, r1, k0, k1} : (u32x4){k0, k1, r0, r1};
                    const int a = rowa[wm * 64 + mi * 32 + 8 * (2 * k2 + (odd ? 1 : 0)) + 4 * hh + (lane & 3)];
                    if (a >= 0) __builtin_amdgcn_raw_buffer_store_b128(o, grs, (unsigned)((a * DEXP + tn * 64 + wn * 32 + (c31 & ~7)) * 2), 0, 16);
                }
        } else {
            int a8[2][4]; float w8[2][4];
#pragma unroll
            for (int mi = 0; mi < 2; ++mi)
#pragma unroll
                for (int a4 = 0; a4 < 4; ++a4) a8[mi][a4] = rowa[wm * 64 + mi * 32 + 8 * a4 + 4 * hh + (lane & 3)];
#pragma unroll
            for (int mi = 0; mi < 2; ++mi)
#pragma unroll
                for (int a4 = 0; a4 < 4; ++a4) w8[mi][a4] = roww[wm * 64 + mi * 32 + 8 * a4 + 4 * hh + (lane & 3)];
#pragma unroll
            for (int mi = 0; mi < 2; ++mi)
#pragma unroll
                for (int a4 = 0; a4 < 4; ++a4) {
                    const int a = a8[mi][a4];
                    const float w = w8[mi][a4];
#pragma unroll
                    for (int ni = 0; ni < 2; ++ni) {
                        float v0 = acc[mi][ni][4 * a4], v1 = acc[mi][ni][4 * a4 + 1], v2 = acc[mi][ni][4 * a4 + 2], v3 = acc[mi][ni][4 * a4 + 3];
                        quad_transpose(v0, v1, v2, v3, lane);
                        if (a >= 0) *(u32x2*)(Y + (size_t)a * D + tn * 128 + wn * 64 + ni * 32 + (c31 & ~3)) = (u32x2){pk2(w * v0, w * v1), pk2(w * v2, w * v3)};
                    }
                }
        }
        pup = up; pslot = e * 72 + j;
        bpre = has_next;
        cdesc = ndesc;
        if (cdesc == -2) {
            if (pup) { asm volatile("s_waitcnt vmcnt(0)" ::: "memory"); __syncthreads(); if (tid == 0) (void)xb_add(&rdy[pslot], 1u); pup = false; }
            MOE_ACQUIRE();
        }
    }
#undef MOE_ACQUIRE
    if (pup) {
        asm volatile("s_waitcnt vmcnt(0)" ::: "memory");
        __syncthreads();
        if (tid == 0) (void)xb_add(&rdy[pslot], 1u);
    }
}

__global__ void __launch_bounds__(NT) fwd_mega(P p_unused) {
    cg::grid_group grid = cg::this_grid();
    __shared__ __attribute__((aligned(16))) unsigned char lds[LDS_BYTES];
#define KA (*kargs())
#define WSP(T, off) ((T*)(kargs()->ws + (off)))
    if (kargs()->ws == nullptr) grid.sync();
    if (threadIdx.x < 4) ((volatile LAS unsigned*)(lds + LDS_XB))[threadIdx.x] = 0u;
    __syncthreads();
    const XcdBarrier bar = xcd_barrier_post(WSP(unsigned, WS_BAR), (volatile LAS unsigned*)(lds + LDS_XB));
    phase_init(KA, WSP(int, WS_CNT), WSP(f32x2, WS_ROPE), lds, WSP(bf16_t, WS_BTIN), WSP(bf16_t, WS_BTOUT), WSP(bf16_t, WS_RT), WSP(f32x4, WS_SSMT), WSP(bf16_t, WS_ZERO), WSP(bf16_t, WS_VTA), WSP(bf16_t, WS_VTD));
#ifndef PROBE
#define PROBE 0
#endif
#if (PROBE) & 0x4000
    xcd_barrier(bar);
    phase_init(KA, WSP(int, WS_CNT), WSP(f32x2, WS_ROPE), lds, WSP(bf16_t, WS_BTIN), WSP(bf16_t, WS_BTOUT), WSP(bf16_t, WS_RT), WSP(f32x4, WS_SSMT), WSP(bf16_t, WS_ZERO), WSP(bf16_t, WS_VTA), WSP(bf16_t, WS_VTD));
#endif
#define REP(bit) for (int rep_ = 0; rep_ < (((PROBE) >> (bit)) & 1) + 1; ++rep_)
    for (int layer = 0; layer < 2; ++layer) {
        phase_norm(KA, layer == 0 ? 0 : 1, kargs()->attn_g + (size_t)layer * D, WSP(float, WS_H), WSP(bf16_t, WS_XN), WSP(bf16_t, WS_Y));
        xcd_barrier(bar);
#if (PROBE) & 0x8000
        if (layer == 0) { phase_norm(KA, 0, kargs()->attn_g, WSP(float, WS_H), WSP(bf16_t, WS_XN), WSP(bf16_t, WS_Y)); xcd_barrier(bar);
                          phase_norm(KA, 0, kargs()->attn_g, WSP(float, WS_H), WSP(bf16_t, WS_XN), WSP(bf16_t, WS_Y)); xcd_barrier(bar); }
#endif
        REP(0) {
            { pg8::Gemm g{WSP(bf16_t, WS_XN), WSP(bf16_t, WS_BTIN) + (size_t)layer * INW * D, MPAD, INW, D}; pg8::StaticOrder S; S.init(MPAD, INW, (int)gridDim.x, (int)blockIdx.x);
              EpiInProj E{WSP(bf16_t, WS_QKV), WSP(bf16_t, WS_KFA), WSP(bf16_t, WS_KFD), WSP(bf16_t, WS_VTA), WSP(bf16_t, WS_VTD), WSP(f32x2, WS_ROPE)};
              pg8::gemm_phase<EpiInProj, pg8::StaticOrder, true, true>((PG8_LAS unsigned char*)lds, g, S, E); }
        xcd_barrier(bar); }
        REP(1) {
        if (blockIdx.x < NBATCH * SSM_G) {
            float* Sl = (float*)(lds + 86016);
            ssm_pass<false>(KA, layer, WSP(bf16_t, WS_QKV), WSP(bf16_t, WS_YB), Sl, lds, WSP(f32x4, WS_SSMT));
            __syncthreads();
            ssm_pass<true>(KA, layer, WSP(bf16_t, WS_QKV), WSP(bf16_t, WS_YB), Sl, lds, WSP(f32x4, WS_SSMT));
        }
        phase_diff(WSP(bf16_t, WS_QKV), WSP(bf16_t, WS_KFD), WSP(bf16_t, WS_VTD), WSP(bf16_t, WS_DTMP));
        phase_swa(KA, layer, WSP(bf16_t, WS_QKV), WSP(bf16_t, WS_KFA), WSP(bf16_t, WS_VTA), WSP(bf16_t, WS_MIX));
        xcd_barrier(bar); }
        phase_gemm_dense<2>(lds, WSP(bf16_t, WS_YB), SSM_W, kargs()->w_glu + (size_t)layer * SSM_W * SSM_W, SSM_W, nullptr, WSP(bf16_t, WS_MIX), WSP(bf16_t, WS_YB), 0, 1, WSP(bf16_t, WS_ZERO), WSP(unsigned, WS_DEP) + layer * DEP_LAYER + DEP_MX);
        phase_diff_combine(KA, layer, WSP(bf16_t, WS_DTMP), WSP(bf16_t, WS_MIX), WSP(unsigned, WS_DEP) + layer * DEP_LAYER + DEP_MX);
        {
            unsigned* dep = WSP(unsigned, WS_DEP) + layer * DEP_LAYER;
            { pg8::Gemm g{WSP(bf16_t, WS_MIX), WSP(bf16_t, WS_BTOUT) + (size_t)layer * D * D, MPG8, D, D}; pg8::StaticOrder S; S.init(MPG8, D, (int)gridDim.x, (int)blockIdx.x);
              EpiOutProj E{WSP(float, WS_H), layer == 0 ? kargs()->x : nullptr, kargs()->meta};
              if (threadIdx.x == 0) { pg8::Unit u; for (int i = 0; S.next(i, u); ++i) XB_SPIN(xb_ld(&dep[DEP_MX + u.pm]) < 14u, WSP(unsigned, WS_BAR));
                                      __builtin_amdgcn_fence(__ATOMIC_ACQUIRE, "agent"); asm volatile("s_waitcnt vmcnt(0)" ::: "memory"); }
              __syncthreads();
              pg8::gemm_phase<EpiOutProj, pg8::StaticOrder, true, true>((PG8_LAS unsigned char*)lds, g, S, E);
              asm volatile("s_waitcnt vmcnt(0)" ::: "memory");
              __syncthreads();
              if (threadIdx.x == 0) { pg8::Unit u; for (int i = 0; S.next(i, u); ++i) (void)xb_add(&dep[DEP_RT + u.pm], 1u); } }
            phase_gemm_dense<3>(lds, WSP(bf16_t, WS_MIX), D, kargs()->w_out + (size_t)layer * D * D, D, WSP(float, WS_Y), nullptr, nullptr, MPG8 / BM, 16, WSP(bf16_t, WS_ZERO), dep + DEP_LO, dep + DEP_MX + MPG8 / 256, WSP(unsigned, WS_BAR));
            __syncthreads();
            phase_router(KA, layer, WSP(float, WS_H), WSP(bf16_t, WS_XN), WSP(float, WS_SELW), WSP(int, WS_LIST), WSP(int, WS_CNT) + layer * NEXP, WSP(bf16_t, WS_RT), lds, WSP(float, WS_Y), dep + DEP_RT, dep + DEP_LO, WSP(unsigned, WS_BAR));
        }
        xcd_barrier(bar);
        phase_moe2(KA, layer, lds, WSP(bf16_t, WS_XN), WSP(bf16_t, WS_G), WSP(bf16_t, WS_Y), WSP(float, WS_SELW), WSP(int, WS_LIST), WSP(int, WS_CNT) + layer * NEXP, WSP(bf16_t, WS_ZERO), WSP(unsigned, WS_DEP) + layer * DEP_LAYER, WSP(unsigned, WS_BAR));
        xcd_barrier(bar);
    }
    phase_norm(KA, 2, kargs()->final_g, WSP(float, WS_H), WSP(bf16_t, WS_XN), WSP(bf16_t, WS_Y));
}

extern "C" void kernel_launch(void* const* d_in, const int* in_sizes, int n_in, void* d_out, int out_size, void* d_ws, size_t ws_size, hipStream_t stream) {
    static int grid_blocks = 0;
    if (!grid_blocks) {
        int dev = 0, cus = 0, per_cu = 0;
        (void)hipGetDevice(&dev);
        (void)hipDeviceGetAttribute(&cus, hipDeviceAttributeMultiprocessorCount, dev);
        (void)hipOccupancyMaxActiveBlocksPerMultiprocessor(&per_cu, fwd_mega, NT, 0);
        if (per_cu < 1) fprintf(stderr, "occupancy query reports %d blocks per CU\n", per_cu);
        grid_blocks = cus;
        if (ws_size < WS_END) fprintf(stderr, "workspace too small: %zu < %zu\n", ws_size, (size_t)WS_END);
    }
    (void)hipMemsetAsync((unsigned char*)d_ws + WS_BAR, 0, 16384, stream);
    P p{};
    const float** pp = (const float**)&p;
    for (int i = 0; i < 29; ++i) pp[i] = (const float*)d_in[i];
    p.out = (float*)d_out; p.ws = (unsigned char*)d_ws;
    void* args[] = {&p};
    hipError_t e = hipLaunchCooperativeKernel((void*)fwd_mega, dim3(grid_blocks), dim3(NT), args, 0, stream);
    if (e != hipSuccess) fprintf(stderr, "cooperative launch failed: %s (grid %d)\n", hipGetErrorString(e), grid_blocks);
}
```
